# Optimizing an MI355X kernel written in HIP

```python
import jax, jax.numpy as jnp
from jax import lax
import numpy as np

D_MODEL = 1024
BATCH = 4
SEQ = 4096
DEPTH = 2

N_MIXERS = 2
N_A = (DEPTH + N_MIXERS - 1) // N_MIXERS
N_B = DEPTH // N_MIXERS

CHUNK = 128
GM_HALF = D_MODEL
GM_GROUPS = 8
GM_GROUP_DIM = GM_HALF // GM_GROUPS

ATT_HEADS = 8
ATT_HEAD_DIM = D_MODEL // ATT_HEADS
KV_LATENT = 256
IDX_HEADS = 8
IDX_DIM = 64
TOPK_MAX = 256
Q_BLOCK = 128
Q_WIDTH = ATT_HEADS * ATT_HEAD_DIM
PROJ_B = Q_WIDTH + KV_LATENT + IDX_HEADS * IDX_DIM + IDX_DIM + IDX_HEADS
SPLITS_B = (Q_WIDTH, Q_WIDTH + KV_LATENT, Q_WIDTH + KV_LATENT + IDX_HEADS * IDX_DIM,
            Q_WIDTH + KV_LATENT + IDX_HEADS * IDX_DIM + IDX_DIM)

N_EGROUPS = 4
EXPERTS_PER_GROUP = 8
N_EXPERTS = N_EGROUPS * EXPERTS_PER_GROUP
TOPK_E = 2
EXPERT_FF = 256

PLE_DIM = 256

ALPHA = (2 * DEPTH) ** 0.25
BETA = (8 * DEPTH) ** -0.25

kernel_name = 'hybrid_gmlp_dsa_hiermoe_deepnorm'


def _layer_norm(x, g, b, eps=1e-5):
    xf = x.astype(jnp.float32)
    mu = jnp.mean(xf, axis=-1, keepdims=True)
    var = jnp.mean(jnp.square(xf - mu), axis=-1, keepdims=True)
    return ((xf - mu) * lax.rsqrt(var + eps)).astype(x.dtype) * g + b


def _rms_norm(x, g, eps=1e-6):
    xf = x.astype(jnp.float32)
    ms = jnp.mean(jnp.square(xf), axis=-1, keepdims=True)
    return (xf * lax.rsqrt(ms + eps)).astype(x.dtype) * g


def chunked_gmlp(x, w_in, b_in, vn_g, vn_b, w_s, b_s, w_out):
    bsz, seq, _ = x.shape
    z = jax.nn.gelu(x @ w_in + b_in, approximate=False)
    u, v = jnp.split(z, 2, axis=-1)
    v = _layer_norm(v, vn_g, vn_b)
    v = v.reshape(bsz, seq // CHUNK, CHUNK, GM_GROUPS, GM_GROUP_DIM)
    causal = jnp.tril(jnp.ones((CHUNK, CHUNK), dtype=bool))
    w_c = jnp.where(causal[None], w_s, jnp.zeros_like(w_s))
    s = jnp.einsum('gts,bcsgd->bctgd', w_c, v) + b_s.T[:, :, None]
    return (u * s.reshape(bsz, seq, GM_HALF)) @ w_out


def dsa_attention(x, w_in, kv_g, w_uk, w_uv, w_out):
    bsz, seq, _ = x.shape
    k_sel = min(TOPK_MAX, seq // 4)
    n_blk = seq // Q_BLOCK
    proj = x @ w_in
    q, c_kv, q_idx, k_idx, w_idx = jnp.split(proj, SPLITS_B, axis=-1)
    q = q.reshape(bsz, seq, ATT_HEADS, ATT_HEAD_DIM)
    c_kv = _rms_norm(c_kv, kv_g)
    q_idx = q_idx.reshape(bsz, seq, IDX_HEADS, IDX_DIM)
    w_idx = w_idx * (IDX_HEADS * IDX_DIM) ** -0.5
    q_lat = jnp.einsum('blhd,hcd->blhc', q, w_uk) * ATT_HEAD_DIM ** -0.5
    key_pos = jnp.arange(seq)

    def to_blocks(a):
        return a.reshape((bsz, n_blk, Q_BLOCK) + a.shape[2:]).swapaxes(0, 1)

    def block(args):
        ql_b, qi_b, wi_b, t0 = args
        tq = t0 + jnp.arange(Q_BLOCK)
        rel = jax.nn.relu(jnp.einsum('bqhd,bsd->bqhs', qi_b, k_idx))
        score = jnp.einsum('bqhs,bqh->bqs', rel, wi_b).astype(jnp.float32)
        causal = key_pos[None, :] <= tq[:, None]
        score = jnp.where(causal[None], score, -jnp.inf)
        _, idx = lax.top_k(score, k_sel)
        c_sel = jax.vmap(lambda c, i: c[i])(c_kv, idx)
        valid = idx <= tq[None, :, None]
        logits = jnp.einsum('bqhc,bqkc->bqhk', ql_b, c_sel).astype(jnp.float32)
        logits = jnp.where(valid[:, :, None, :], logits, -jnp.inf)
        probs = jax.nn.softmax(logits, axis=-1).astype(c_sel.dtype)
        return jnp.einsum('bqhk,bqkc->bqhc', probs, c_sel)

    o = lax.map(block, (to_blocks(q_lat), to_blocks(q_idx), to_blocks(w_idx),
                        jnp.arange(n_blk) * Q_BLOCK))
    o = o.swapaxes(0, 1).reshape(bsz, seq, ATT_HEADS, KV_LATENT)
    o = jnp.einsum('blhc,hcd->blhd', o, w_uv).reshape(bsz, seq, Q_WIDTH)
    return o @ w_out


def hier_moe(x, wg, bg, we, be, w_in, w_out):
    bsz, seq, dm = x.shape
    xt = x.reshape(bsz * seq, dm)
    g_logit = (xt @ wg + bg).astype(jnp.float32)
    g_prob = jax.nn.softmax(g_logit, axis=-1)
    g_sel = jnp.argmax(g_logit, axis=-1)
    p_g = jnp.take_along_axis(g_prob, g_sel[:, None], axis=1)[:, 0]
    e_logit = (xt @ we + be).astype(jnp.float32).reshape(-1, N_EGROUPS, EXPERTS_PER_GROUP)
    e_logit = jnp.take_along_axis(e_logit, g_sel[:, None, None], axis=1)[:, 0]
    top_p, top_i = lax.top_k(jax.nn.softmax(e_logit, axis=-1), TOPK_E)
    top_p = top_p / jnp.sum(top_p, axis=-1, keepdims=True) * p_g[:, None]
    in_group = jnp.sum(jax.nn.one_hot(top_i, EXPERTS_PER_GROUP) * top_p[..., None], axis=1)
    gate = (jax.nn.one_hot(g_sel, N_EGROUPS)[:, :, None] * in_group[:, None, :]).astype(x.dtype)
    w_in_g = w_in.reshape(N_EGROUPS, EXPERTS_PER_GROUP, dm, 2 * EXPERT_FF)
    w_out_g = w_out.reshape(N_EGROUPS, EXPERTS_PER_GROUP, EXPERT_FF, dm)
    out = jnp.zeros_like(xt)
    for g in range(N_EGROUPS):
        h = jnp.einsum('td,edf->tef', xt, w_in_g[g])
        a, b = jnp.split(h, 2, axis=-1)
        h = jax.nn.silu(a) * b * gate[:, g, :, None]
        out = out + jnp.einsum('tef,efd->td', h, w_out_g[g])
    return out.reshape(bsz, seq, dm)


def setup_inputs(seed: int = 0) -> dict:
    key = jax.random.key(seed)
    ks = iter(jax.random.split(key, 40))

    def nrm(shape, scale):
        return jax.random.normal(next(ks), shape, jnp.float32) * scale

    def gain(shape):
        return 1.0 + nrm(shape, 0.05)

    d = D_MODEL
    return {
        'x': nrm((BATCH, SEQ, d), 1.0),
        'p': nrm((DEPTH, BATCH, SEQ, PLE_DIM), 1.0),
        'a_w_in': nrm((N_A, d, 2 * GM_HALF), d ** -0.5),
        'a_b_in': nrm((N_A, 2 * GM_HALF), 0.02),
        'a_vn_g': gain((N_A, GM_HALF)),
        'a_vn_b': nrm((N_A, GM_HALF), 0.02),
        'a_w_s': nrm((N_A, GM_GROUPS, CHUNK, CHUNK), CHUNK ** -0.5),
        'a_b_s': 1.0 + nrm((N_A, GM_GROUPS, CHUNK), 0.1),
        'a_w_out': nrm((N_A, GM_HALF, d), BETA * GM_HALF ** -0.5),
        'b_w_in': nrm((N_B, d, PROJ_B), d ** -0.5),
        'b_kv_g': gain((N_B, KV_LATENT)),
        'b_w_uk': nrm((N_B, ATT_HEADS, KV_LATENT, ATT_HEAD_DIM), KV_LATENT ** -0.5),
        'b_w_uv': nrm((N_B, ATT_HEADS, KV_LATENT, ATT_HEAD_DIM), KV_LATENT ** -0.5),
        'b_w_out': nrm((N_B, Q_WIDTH, d), BETA * Q_WIDTH ** -0.5),
        'ln1_g': gain((DEPTH, d)),
        'ln1_b': nrm((DEPTH, d), 0.02),
        'ln2_g': gain((DEPTH, d)),
        'ln2_b': nrm((DEPTH, d), 0.02),
        'r_wg': nrm((DEPTH, d, N_EGROUPS), d ** -0.5),
        'r_bg': nrm((DEPTH, N_EGROUPS), 0.01),
        'r_we': nrm((DEPTH, d, N_EXPERTS), d ** -0.5),
        'r_be': nrm((DEPTH, N_EXPERTS), 0.01),
        'e_w_in': nrm((DEPTH, N_EXPERTS, d, 2 * EXPERT_FF), d ** -0.5),
        'e_w_out': nrm((DEPTH, N_EXPERTS, EXPERT_FF, d), BETA * EXPERT_FF ** -0.5),
        'ple_w': nrm((DEPTH, PLE_DIM, d), PLE_DIM ** -0.5),
        'ple_gw': nrm((DEPTH, d, d), d ** -0.5),
        'ple_gb': nrm((DEPTH, d), 0.02),
    }


def reference(x, p, a_w_in, a_b_in, a_vn_g, a_vn_b, a_w_s, a_b_s, a_w_out,
              b_w_in, b_kv_g, b_w_uk, b_w_uv, b_w_out,
              ln1_g, ln1_b, ln2_g, ln2_b,
              r_wg, r_bg, r_we, r_be, e_w_in, e_w_out,
              ple_w, ple_gw, ple_gb):
    for i in range(DEPTH):
        j = i // N_MIXERS
        if i % N_MIXERS == 0:
            mix = chunked_gmlp(x, a_w_in[j], a_b_in[j], a_vn_g[j], a_vn_b[j],
                               a_w_s[j], a_b_s[j], a_w_out[j])
        else:
            mix = dsa_attention(x, b_w_in[j], b_kv_g[j], b_w_uk[j], b_w_uv[j], b_w_out[j])
        x = _layer_norm(ALPHA * x + mix, ln1_g[i], ln1_b[i])
        ffn = hier_moe(x, r_wg[i], r_bg[i], r_we[i], r_be[i], e_w_in[i], e_w_out[i])
        x = _layer_norm(ALPHA * x + ffn, ln2_g[i], ln2_b[i])
        x = x + (p[i] @ ple_w[i]) * jax.nn.sigmoid(x @ ple_gw[i] + ple_gb[i])
    return x
```

```cpp
#include <hip/hip_runtime.h>
#include <cstdio>
#include <cstdint>

constexpr int D = 1024, BATCH = 4, SEQ = 4096, T = BATCH * SEQ;
constexpr int CHUNK = 128, GM_G = 8;
constexpr int KVL = 256, IDXH = 8, IDXD = 64, TOPK = 256, NH = 8, HD_ = 128;
constexpr int PROJ_B = 1864;
constexpr int NEXP = 32, EFF = 256, PLE = 256;
constexpr float ALPHA = 1.41421356237309515f;


#define GAS __attribute__((address_space(1)))
#define LAS __attribute__((address_space(3)))
typedef unsigned short bf16;
typedef unsigned v4u __attribute__((ext_vector_type(4)));
typedef unsigned v2u __attribute__((ext_vector_type(2)));
typedef float f32x4 __attribute__((ext_vector_type(4)));
typedef float f32x2 __attribute__((ext_vector_type(2)));
typedef float f32x16 __attribute__((ext_vector_type(16)));
typedef short bf16x8 __attribute__((ext_vector_type(8)));
typedef short bf16x4 __attribute__((ext_vector_type(4)));
#define LDS_WAIT() asm volatile("s_waitcnt lgkmcnt(0)" ::: "memory")
#define VM_WAIT() asm volatile("s_waitcnt vmcnt(0)" ::: "memory")
__device__ __forceinline__ unsigned f2bf(float f) { unsigned u = __builtin_bit_cast(unsigned, f); return (u + 0x7fffu + ((u >> 16) & 1u)) >> 16; }
__device__ __forceinline__ unsigned pk2(float lo, float hi) { unsigned r; asm("v_cvt_pk_bf16_f32 %0, %1, %2" : "=v"(r) : "v"(lo), "v"(hi)); return r; }
__device__ __forceinline__ float bf2f(unsigned short h) { return __builtin_bit_cast(float, (unsigned)h << 16); }
__device__ __forceinline__ float bflo(unsigned w) { return __builtin_bit_cast(float, w << 16); }
__device__ __forceinline__ float bfhi(unsigned w) { return __builtin_bit_cast(float, w & 0xffff0000u); }

namespace pg8 {
constexpr int BM = 256, BK = 64, HALF = 128, HTB = HALF * BK * 2  , STAGE_BYTES = 8 * HTB, NXCD = 8, WGM = 8;
__host__ __device__ __forceinline__ int lds_byte(int r, int c) { const int st = (r >> 4) * 2 + (c >> 5), rr = r & 15, cc = c & 31, ob = rr * 64 + cc * 2; return st * 1024 + (ob ^ (((ob >> 9) & 1) << 5)); }
__host__ __device__ __forceinline__ void stage_rc(int b, int& R, int& C) { const int st = b / 1024, sb = b % 1024, swz = sb ^ (((sb >> 9) & 1) << 5); R = (st >> 1) * 16 + swz / 64; C = (st & 1) * 32 + (swz % 64) / 2; }
__host__ __device__ __forceinline__ int perm32(int rho) { const int n = rho >> 4, i = rho & 15; return 8 * (i >> 2) + 4 * n + (i & 3); }

struct Unit { const char* a; const char* b; int row0, col0, aux; const int* rows; int nrows; };
struct Gemm { int K, lda, ldb; };

struct StaticOrder {
    int nM, nN, nwg, G, c; const char* A; const char* Bt; size_t sa, sb;
    __device__ void init(int M, int N, int G_, int c_, const void* A_, const void* Bt_, int lda, int ldb) { nM = M / BM; nN = N / BM; nwg = nM * nN; G = G_; c = c_; A = (const char*)A_; Bt = (const char*)Bt_; sa = (size_t)BM * lda * 2; sb = (size_t)BM * ldb * 2; }
    __device__ bool next(int i, Unit& u) const {
        const long L = (long)i * G + c; if (L >= nwg) return false;
        int wgid = (int)L; { const int q = nwg / NXCD, r = nwg % NXCD, xcd = wgid % NXCD, off = wgid / NXCD; wgid = (xcd < r ? xcd * (q + 1) : r * (q + 1) + (xcd - r) * q) + off; }
        const int nig = WGM * nN, gid = wgid / nig, fm = gid * WGM, gsz = (nM - fm) < WGM ? (nM - fm) : WGM;
        const int pm = fm + ((wgid % nig) % gsz), pn = (wgid % nig) / gsz;
        u.a = A + (size_t)pm * sa; u.b = Bt + (size_t)pn * sb; u.row0 = pm * BM; u.col0 = pn * BM; u.aux = 0; u.rows = nullptr; u.nrows = 256; return true;
    }
    __device__ __forceinline__ void ready(const Unit&) const {}
    __device__ __forceinline__ void ready_first(const Unit&) const {}
    __device__ __forceinline__ void done(const Unit&) const {}
};

__device__ __forceinline__ unsigned cvt_pk_bf16(float lo, float hi) { unsigned r; asm volatile("v_cvt_pk_bf16_f32 %0, %1, %2" : "=v"(r) : "v"(lo), "v"(hi)); return r; }
__device__ __forceinline__ f32x2 gelu_pk(f32x2 v) {
    const f32x2 av = __builtin_elementwise_abs(v), d = av * 0.2316418882f + 1.0f;
    f32x2 t; t.x = __builtin_amdgcn_rcpf(d.x); t.y = __builtin_amdgcn_rcpf(d.y);
    f32x2 q = t * 0.5307027145f + (-0.7265760135f); q = q * t + 0.7107068705f; q = q * t + (-0.142248368f); q = q * t + 0.127414796f; q = q * t;
    const f32x2 s = (v * v) * (-0.72134752044f);
    f32x2 e; e.x = __builtin_amdgcn_exp2f(s.x); e.y = __builtin_amdgcn_exp2f(s.y);
    const f32x2 m = v * (q * e), r = v - m;
    f32x2 o; o.x = v.x < 0.f ? m.x : r.x; o.y = v.y < 0.f ? m.y : r.y; return o;
}

template <int ACT> struct EpiBf16 {
    static constexpr bool PERM = true;
    bf16* O; int ldc; const float* bias; float scale;
    __device__ __forceinline__ void operator()(const f32x4 (&acc)[2][2][4][2], const Unit& u, int wr, int wc, int fr, int fq) const {
        const int row0 = u.row0 + wr * 64 + fr; const int col0 = u.col0 + wc * 32 + 8 * fq;
        f32x4 bv[2][2];
#pragma unroll
        for (int bj = 0; bj < 2; ++bj)
#pragma unroll
            for (int n = 0; n < 2; ++n) bv[bj][n] = bias ? *(const f32x4*)(bias + col0 + bj * HALF + 4 * n) : (f32x4){0.f, 0.f, 0.f, 0.f};
#pragma unroll
        for (int ai = 0; ai < 2; ++ai)
#pragma unroll
            for (int m = 0; m < 4; ++m) { bf16* rowp = O + (size_t)(row0 + ai * HALF + m * 16) * ldc + col0;
#pragma unroll
                for (int bj = 0; bj < 2; ++bj) { f32x4 v0 = acc[ai][bj][m][0] + bv[bj][0], v1 = acc[ai][bj][m][1] + bv[bj][1];
                    if (ACT == 1) { f32x2 a = gelu_pk((f32x2){v0[0], v0[1]}), b = gelu_pk((f32x2){v0[2], v0[3]}), c = gelu_pk((f32x2){v1[0], v1[1]}), d = gelu_pk((f32x2){v1[2], v1[3]});
                        v0 = (f32x4){a.x, a.y, b.x, b.y}; v1 = (f32x4){c.x, c.y, d.x, d.y}; }
                    v0 = v0 * scale; v1 = v1 * scale; v4u w; w.x = cvt_pk_bf16(v0[0], v0[1]); w.y = cvt_pk_bf16(v0[2], v0[3]); w.z = cvt_pk_bf16(v1[0], v1[1]); w.w = cvt_pk_bf16(v1[2], v1[3]);
                    *(v4u*)(rowp + bj * HALF) = w; } }
    }
};
template <bool XF32> struct EpiRes {
    static constexpr bool PERM = false;
    const void* X; bf16* R; int ldc; float alpha;
    __device__ __forceinline__ void operator()(const f32x4 (&acc)[2][2][4][2], const Unit& u, int wr, int wc, int fr, int fq) const {
        const int col0 = u.col0 + wc * 32 + 4 * fq;
#pragma unroll
        for (int ai = 0; ai < 2; ++ai)
#pragma unroll
            for (int m = 0; m < 4; ++m) { const size_t off = (size_t)(u.row0 + ai * HALF + wr * 64 + m * 16 + fr) * ldc + col0;
#pragma unroll
                for (int bj = 0; bj < 2; ++bj)
#pragma unroll
                    for (int n = 0; n < 2; ++n) { f32x4 xs;
                        if (XF32) xs = *(const f32x4*)((const float*)X + off + bj * HALF + n * 16);
                        else { const v2u xb = *(const v2u*)((const bf16*)X + off + bj * HALF + n * 16); xs = (f32x4){bflo(xb.x), bfhi(xb.x), bflo(xb.y), bfhi(xb.y)}; }
                        const f32x4 r = xs * alpha + acc[ai][bj][m][n]; v2u o; o.x = cvt_pk_bf16(r[0], r[1]); o.y = cvt_pk_bf16(r[2], r[3]);
                        *(v2u*)(R + off + bj * HALF + n * 16) = o; } }
    }
};

template <class Epi, class Sched, bool GATHER = false>
__device__ __forceinline__ void gemm_phase(LAS unsigned char* lds, const Gemm g, const Sched& S, const Epi& E) {
    int tid_ = threadIdx.x; asm volatile("" : "+v"(tid_));
    const int tid = tid_, wid = __builtin_amdgcn_readfirstlane(tid >> 6), lane = tid & 63, wr = wid >> 2, wc = wid & 3, fr = lane & 15, fq = lane >> 4;
    const int K = g.K, nt = K / BK;
    unsigned voffA[2], voffB[2]; int RA[2], CA[2];
#pragma unroll
    for (int i = 0; i < 2; ++i) { int R, C; stage_rc(tid * 16 + i * 8192, R, C); const int Rb = Epi::PERM ? ((R & ~31) + perm32(R & 31)) : R; RA[i] = R; CA[i] = C;
        voffA[i] = (unsigned)(R * g.lda + C) * 2u; voffB[i] = (unsigned)(Rb * g.ldb + C) * 2u; }
    const size_t kstep = (size_t)(BK * 2);
    const size_t hstepA = GATHER ? 0 : (size_t)HALF * g.lda * 2, hstepB = (size_t)HALF * g.ldb * 2;
    const unsigned ldsw = (unsigned)wid * 1024u;
    const int aoff = lds_byte(wr * 64 + fr, fq * 8), boff = lds_byte(wc * 32 + fr, fq * 8);
    unsigned gc[2][2], gn[2][2];
#define PG8_SA(b, h) (((b) * 2 + (h)) * HTB)
#define PG8_SB(b, h) ((4 + (b) * 2 + (h)) * HTB)
#define PG8_GLDS(bufoff, gptr, i_) __builtin_amdgcn_global_load_lds((const unsigned*)(gptr), (LAS unsigned*)(lds + (bufoff) + ldsw + (i_) * 8192), 16, 0, 0)
#define PG8_STAGEB(bufoff, gbase) do { PG8_GLDS(bufoff, (const char*)(gbase) + voffB[0], 0); PG8_GLDS(bufoff, (const char*)(gbase) + voffB[1], 1); } while (0)
#define PG8_STAGEA(bufoff, kp, h, nx) do { if constexpr (GATHER) { const unsigned o0 = (nx) ? gn[h][0] : gc[h][0], o1 = (nx) ? gn[h][1] : gc[h][1]; \
            PG8_GLDS(bufoff, (const char*)(kp) + o0, 0); PG8_GLDS(bufoff, (const char*)(kp) + o1, 1); } \
        else { PG8_GLDS(bufoff, (const char*)(kp) + (h) * hstepA + voffA[0], 0); PG8_GLDS(bufoff, (const char*)(kp) + (h) * hstepA + voffA[1], 1); } } while (0)
#define PG8_LDA(dst, b, h) do { _Pragma("unroll") for (int m = 0; m < 4; ++m) _Pragma("unroll") for (int k = 0; k < 2; ++k) dst[m][k] = *(const LAS bf16x8*)(lds + PG8_SA(b, h) + aoff + m * 2048 + k * 1024); } while (0)
#define PG8_LDB(dst, b, h) do { _Pragma("unroll") for (int n = 0; n < 2; ++n) _Pragma("unroll") for (int k = 0; k < 2; ++k) dst[n][k] = *(const LAS bf16x8*)(lds + PG8_SB(b, h) + boff + n * 2048 + k * 1024); } while (0)
#define PG8_MMA(ai, bj, At, Bt) do { __builtin_amdgcn_s_setprio(1); _Pragma("unroll") for (int m = 0; m < 4; ++m) _Pragma("unroll") for (int n = 0; n < 2; ++n) _Pragma("unroll") for (int k = 0; k < 2; ++k) \
        acc[ai][bj][m][n] = __builtin_amdgcn_mfma_f32_16x16x32_bf16(Bt[n][k], At[m][k], acc[ai][bj][m][n], 0, 0, 0); __builtin_amdgcn_s_setprio(0); } while (0)
#define PG8_WAIT_V(n) asm volatile("s_waitcnt vmcnt(" #n ")" ::: "memory")
#define PG8_WAIT_L(n) asm volatile("s_waitcnt lgkmcnt(" #n ")" ::: "memory")
#define PG8_BAR __builtin_amdgcn_s_barrier()
#define PG8_SCHED __builtin_amdgcn_sched_barrier(0)
#define PG8_GOFF(dst, u) do { _Pragma("unroll") for (int h_ = 0; h_ < 2; ++h_) _Pragma("unroll") for (int i_ = 0; i_ < 2; ++i_) { const int e_ = h_ * HALF + RA[i_]; \
        const int tok_ = (e_ < (u).nrows) ? (u).rows[e_] : 0; dst[h_][i_] = (unsigned)(tok_ * g.lda + CA[i_]) * 2u; } } while (0)
    Unit cur, nxt; int ui = 0;
    if (!S.next(0, cur)) return;
    f32x4 acc[2][2][4][2];
#pragma unroll
    for (int a = 0; a < 2; ++a)
#pragma unroll
        for (int b = 0; b < 2; ++b)
#pragma unroll
            for (int m = 0; m < 4; ++m)
#pragma unroll
                for (int n = 0; n < 2; ++n) acc[a][b][m][n] = (f32x4){0.f, 0.f, 0.f, 0.f};
    bf16x8 At[4][2], B0[2][2], B1[2][2];
    const char* cA = cur.a; const char* cB = cur.b;
    S.ready_first(cur);
    if constexpr (GATHER) { PG8_GOFF(gc, cur); VM_WAIT(); }
    PG8_STAGEB(PG8_SB(0, 0), cB); PG8_STAGEB(PG8_SB(0, 1), cB + hstepB); PG8_STAGEA(PG8_SA(0, 0), cA, 0, false); PG8_STAGEA(PG8_SA(0, 1), cA, 1, false);
    if (wr == 1) PG8_BAR;
    PG8_WAIT_V(2); PG8_BAR;
    PG8_STAGEB(PG8_SB(1, 0), cB + kstep); PG8_STAGEA(PG8_SA(1, 0), cA + kstep, 0, false); PG8_STAGEB(PG8_SB(1, 1), cB + hstepB + kstep);
    PG8_WAIT_V(6); PG8_BAR;
    for (;;) {
        const bool has_next = S.next(ui + 1, nxt);
        if (has_next) S.ready(nxt);
        const char* nA = has_next ? nxt.a : cA; const char* nB = has_next ? nxt.b : cB;
        if constexpr (GATHER) { if (has_next) { PG8_GOFF(gn, nxt); } else { _Pragma("unroll") for (int h_ = 0; h_ < 2; ++h_) _Pragma("unroll") for (int i_ = 0; i_ < 2; ++i_) gn[h_][i_] = gc[h_][i_]; }
            VM_WAIT(); }
        for (int t = 0; t < nt; t += 2) {
            const bool last = (t == nt - 2);
            const char* a1 = cA + (size_t)(t + 1) * kstep;
            const char* a2 = last ? nA : cA + (size_t)(t + 2) * kstep; const char* b2 = last ? nB : cB + (size_t)(t + 2) * kstep;
            const char* a3 = a2 + kstep; const char* b3 = b2 + kstep;
            PG8_LDB(B0, 0, 0); PG8_LDB(B1, 0, 1); PG8_SCHED; PG8_LDA(At, 0, 0); PG8_STAGEA(PG8_SA(1, 1), a1, 1, false);
            PG8_WAIT_V(8); PG8_WAIT_L(0); PG8_BAR; PG8_MMA(0, 0, At, B0); PG8_MMA(0, 1, At, B1); PG8_BAR; PG8_SCHED;
            PG8_LDA(At, 0, 1); PG8_STAGEB(PG8_SB(0, 0), b2); PG8_STAGEB(PG8_SB(0, 1), b2 + hstepB); PG8_STAGEA(PG8_SA(0, 0), a2, 0, last);
            PG8_WAIT_V(8); PG8_WAIT_L(0); PG8_BAR; PG8_MMA(1, 0, At, B0); PG8_MMA(1, 1, At, B1); PG8_BAR; PG8_SCHED;
            PG8_LDB(B0, 1, 0); PG8_LDB(B1, 1, 1); PG8_SCHED; PG8_LDA(At, 1, 0); PG8_STAGEA(PG8_SA(0, 1), a2, 1, last);
            PG8_WAIT_V(8); PG8_WAIT_L(0); PG8_BAR; PG8_MMA(0, 0, At, B0); PG8_MMA(0, 1, At, B1); PG8_BAR; PG8_SCHED;
            PG8_LDA(At, 1, 1); PG8_STAGEB(PG8_SB(1, 0), b3); PG8_STAGEB(PG8_SB(1, 1), b3 + hstepB); PG8_STAGEA(PG8_SA(1, 0), a3, 0, last);
            PG8_WAIT_V(8); PG8_WAIT_L(0); PG8_BAR; PG8_MMA(1, 0, At, B0); PG8_MMA(1, 1, At, B1); PG8_BAR; PG8_SCHED;
        }
        if (wr == 0) PG8_BAR;
        E(acc, cur, wr, wc, fr, fq);
        S.done(cur);
        if (!has_next) break;
#pragma unroll
        for (int a = 0; a < 2; ++a)
#pragma unroll
            for (int b = 0; b < 2; ++b)
#pragma unroll
                for (int m = 0; m < 4; ++m)
#pragma unroll
                    for (int n = 0; n < 2; ++n) acc[a][b][m][n] = (f32x4){0.f, 0.f, 0.f, 0.f};
        cur = nxt; cA = nA; cB = nB; ++ui;
        if constexpr (GATHER) { _Pragma("unroll") for (int h_ = 0; h_ < 2; ++h_) _Pragma("unroll") for (int i_ = 0; i_ < 2; ++i_) gc[h_][i_] = gn[h_][i_]; }
        if (wr == 1) PG8_BAR;
    }
    PG8_WAIT_V(0);
    PG8_BAR;
#undef PG8_SA
#undef PG8_SB
#undef PG8_GLDS
#undef PG8_STAGEA
#undef PG8_STAGEB
#undef PG8_LDA
#undef PG8_LDB
#undef PG8_MMA
#undef PG8_WAIT_V
#undef PG8_WAIT_L
#undef PG8_BAR
#undef PG8_SCHED
#undef PG8_GOFF
}
}

constexpr size_t MiB = 1u << 20;
constexpr size_t WS_CTL = 0;
constexpr size_t CTL_ZERO_BYTES = 64 * 1024;
constexpr size_t WS_SMALL = 1 * MiB;
constexpr size_t WS_WA_IN = 8 * MiB;
constexpr size_t WS_WA_OUT = WS_WA_IN + 4 * MiB;
constexpr size_t WS_WB_IN = WS_WA_OUT + 2 * MiB;
constexpr size_t WS_WB_COMB = WS_WB_IN + 6 * MiB;
constexpr size_t WS_WBQ = WS_WB_COMB + 4 * MiB;
constexpr size_t WS_WBOUT = WS_WBQ + 2 * MiB;
constexpr size_t WS_WUK = WS_WBOUT + 2 * MiB;
constexpr size_t WS_WUV = WS_WUK + MiB / 2;
constexpr size_t WS_WE_IN = WS_WUV + MiB / 2;
constexpr size_t WS_WE_OUT = WS_WE_IN + 64 * MiB;
constexpr size_t WS_WP = WS_WE_OUT + 32 * MiB;
constexpr size_t WS_WG = WS_WP + 1 * MiB;
constexpr size_t WS_WEND = WS_WG + 4 * MiB;
static_assert(WS_WEND == 130 * MiB, "weights map");
constexpr size_t WS_PB = 130 * MiB;
constexpr size_t WS_A = 146 * MiB;
constexpr size_t WS_B = 178 * MiB;
constexpr size_t WS_C = 242 * MiB;
constexpr size_t WS_D = 306 * MiB;
constexpr size_t WS_E = 330 * MiB;
constexpr size_t WS_F = 414 * MiB;
constexpr size_t WS_G = 478 * MiB;
constexpr size_t WS_END = 510 * MiB;
constexpr size_t WS_KF = WS_G + 16 * MiB;

constexpr size_t WS_LIST = WS_SMALL;
constexpr size_t WS_GLIST = WS_SMALL + 2 * MiB;
constexpr size_t WS_TOK2 = WS_SMALL + 4 * MiB;
constexpr size_t WS_RWT = WS_SMALL + 5 * MiB;
constexpr int CW_COUNTS = 12288;
constexpr int MAXTILES = 160;

#ifndef DUP_MASK
#define DUP_MASK 0
#endif
#ifndef P10_DUP_SCORE
#define P10_DUP_SCORE 0
#endif
#ifndef P10_DUP_SEL
#define P10_DUP_SEL 0
#endif
#ifndef P11_DUP_QK
#define P11_DUP_QK 0
#endif
#ifndef P11_DUP_WR
#define P11_DUP_WR 0
#endif
#ifndef P11_DUP_LD
#define P11_DUP_LD 0
#endif
#ifndef P4_DUP_ROUTER
#define P4_DUP_ROUTER 0
#endif
#ifndef BAR_DUP
#define BAR_DUP 0
#endif
#ifndef SEL_DUP_HIST
#define SEL_DUP_HIST 0
#endif
#ifndef SEL_DUP_EMIT
#define SEL_DUP_EMIT 0
#endif
#ifndef SEL_DUP_BIS
#define SEL_DUP_BIS 0
#endif
constexpr int NWAVES = 8;
constexpr int RING_BYTES = 131072;
constexpr int LDS_BYTES = 163840;
constexpr int XTRA_OFF = RING_BYTES;


#define XB_TMO      128
#define XB_XCNT(j)  (256  + 64 * (j))
#define XB_XSUB(j)  (1280 + 64 * (j))
#define XB_XGEN(j)  (2304 + 64 * (j))
#define XB_TOP      3328
#define XB_TOPGEN   3392
#define XCD_BAR_WORDS 3456
#define XB_SPIN_CAP (1u << 22)
constexpr int CW_BAR = 1024;
constexpr int BAR_LDS_OFF = LDS_BYTES - 64;
__device__ __forceinline__ unsigned xb_ld(unsigned* p)              { return __hip_atomic_load(p, __ATOMIC_RELAXED, __HIP_MEMORY_SCOPE_AGENT); }
__device__ __forceinline__ unsigned xb_add(unsigned* p, unsigned v) { return __hip_atomic_fetch_add(p, v, __ATOMIC_RELAXED, __HIP_MEMORY_SCOPE_AGENT); }
__device__ __forceinline__ unsigned xb_xcc_id() { return (unsigned)__builtin_amdgcn_s_getreg((3 << 11) | 20) & 0xFu; }
#define XB_SPIN(cond, bar) do { unsigned _sp = 0; while (cond) { __builtin_amdgcn_s_sleep(1); \
    if ((++_sp & 255u) == 0u) { if (xb_ld(&(bar)[XB_TMO])) break; if (_sp > XB_SPIN_CAP) { atomicAdd(&(bar)[XB_TMO], 1u); break; } } } } while (0)
struct XcdBarrier { unsigned* bar; unsigned x; volatile LAS unsigned* st; };
__device__ __forceinline__ XcdBarrier xcd_barrier_post(unsigned* bar, volatile LAS unsigned* st) {
    XcdBarrier b; b.bar = bar; b.x = xb_xcc_id(); b.st = st;
    if (threadIdx.x == 0) (void)xb_add(&bar[XB_XCNT(b.x)], 1u);
    return b;
}
__device__ __forceinline__ void xcd_barrier_complete(unsigned* bar, unsigned x, unsigned& nloc, unsigned& nx) {
    const unsigned G = gridDim.x * gridDim.y * gridDim.z;
    unsigned sum, cnt, mine, sp = 0u;
    for (;;) {
        sum = 0u; cnt = 0u; mine = 0u;
#pragma unroll
        for (unsigned j = 0; j < 16; ++j) { const unsigned c = xb_ld(&bar[XB_XCNT(j)]); sum += c; cnt += (c > 0u) ? 1u : 0u; mine = (j == x) ? c : mine; }
        if (sum == G) break;
        __builtin_amdgcn_s_sleep(1);
        if ((++sp & 255u) == 0u) { if (xb_ld(&bar[XB_TMO])) break; if (sp > XB_SPIN_CAP) { atomicAdd(&bar[XB_TMO], 1u); break; } }
    }
    nloc = mine > 0u ? mine : 1u; nx = cnt > 0u ? cnt : 1u;
}
__device__ __forceinline__ void xcd_barrier(const XcdBarrier& b) {
    asm volatile("s_waitcnt vmcnt(0)" ::: "memory");
    __syncthreads();
    if (threadIdx.x == 0) {
        unsigned* bar = b.bar;
        __builtin_amdgcn_s_waitcnt(0);
        unsigned nloc = b.st[0], nx = b.st[1];
        if (nloc == 0u) { xcd_barrier_complete(bar, b.x, nloc, nx); b.st[0] = nloc; b.st[1] = nx; }
        const unsigned old = xb_add(&bar[XB_XSUB(b.x)], 1u);
        const unsigned gen = old / nloc;
        if (old + 1u == (gen + 1u) * nloc) {
            __builtin_amdgcn_fence(__ATOMIC_RELEASE, "agent");
            asm volatile("s_waitcnt vmcnt(0)" ::: "memory");
            const unsigned og = xb_add(&bar[XB_TOP], 1u);
            const unsigned tg = og / nx;
            if (og + 1u == (tg + 1u) * nx) xb_add(&bar[XB_TOPGEN], 1u);
            else XB_SPIN(xb_ld(&bar[XB_TOPGEN]) == tg, bar);
            __builtin_amdgcn_fence(__ATOMIC_ACQUIRE, "agent");
            xb_add(&bar[XB_XGEN(b.x)], 1u);
            asm volatile("s_waitcnt vmcnt(0)" ::: "memory");
        } else {
            XB_SPIN(xb_ld(&bar[XB_XGEN(b.x)]) == gen, bar);
            __builtin_amdgcn_fence(__ATOMIC_ACQUIRE, "agent");
            asm volatile("s_waitcnt vmcnt(0)" ::: "memory");
        }
    }
    __syncthreads();
}

struct Args { const float* in[27]; float* out; unsigned char* ws; int ph_lo, ph_hi, li, pad; };

struct Frame {
    LAS unsigned char* lds;
    int wave, vcu, G;
    unsigned char* ws;
};

__device__ __forceinline__ void cvt_t_item(const float* src, int ldsrc, int k0, int n0, int nvalid, bf16* dst, int ldk, int drow0, LAS float* scr, int lane) {
    const int nn = 4 * (lane & 15), kq = lane >> 4;
    if (n0 + 64 <= nvalid) {
#pragma unroll
        for (int i = 0; i < 16; ++i) { const int k = kq + 4 * i; const f32x4 v = *(const f32x4*)(src + (size_t)(k0 + k) * ldsrc + n0 + nn);
            scr[k * 65 + nn + 0] = v[0]; scr[k * 65 + nn + 1] = v[1]; scr[k * 65 + nn + 2] = v[2]; scr[k * 65 + nn + 3] = v[3]; }
    } else {
#pragma unroll
        for (int i = 0; i < 16; ++i) { const int k = kq + 4 * i;
#pragma unroll
            for (int e = 0; e < 4; ++e) scr[k * 65 + nn + e] = (n0 + nn + e < nvalid) ? src[(size_t)(k0 + k) * ldsrc + n0 + nn + e] : 0.f; }
    }
    LDS_WAIT(); asm volatile("" ::: "memory");
    const int kc = lane & 7;
#pragma unroll
    for (int jj = 0; jj < 8; ++jj) { const int n = (lane >> 3) + 8 * jj; const LAS float* s = scr + (8 * kc) * 65 + n;
        v4u o; o.x = pk2(s[0 * 65], s[1 * 65]); o.y = pk2(s[2 * 65], s[3 * 65]); o.z = pk2(s[4 * 65], s[5 * 65]); o.w = pk2(s[6 * 65], s[7 * 65]);
        *(v4u*)(dst + (size_t)(drow0 + n) * ldk + k0 + 8 * kc) = o; }
    LDS_WAIT(); asm volatile("" ::: "memory");
}
__device__ __forceinline__ void cvt_rows(const float* src, int ldsrc, bf16* dst, int ldd, int rows, int cols, int gw, int NGW, int lane) {
    const int cpr = cols / 8, sh = 31 - __builtin_clz(cpr); const int total = rows * cpr;
    for (int i = gw * 64 + lane; i < total; i += NGW * 64) { const int r = i >> sh; const int c = (i & (cpr - 1)) * 8;
        const f32x4 a = *(const f32x4*)(src + (size_t)r * ldsrc + c), b = *(const f32x4*)(src + (size_t)r * ldsrc + c + 4);
        v4u o; o.x = pk2(a[0], a[1]); o.y = pk2(a[2], a[3]); o.z = pk2(b[0], b[1]); o.w = pk2(b[2], b[3]);
        *(v4u*)(dst + (size_t)r * ldd + c) = o; }
}
__device__ __forceinline__ void p0_convert(Frame& F, const Args& args) {
    LAS float* scr = (LAS float*)(F.lds + F.wave * 16640);
    const int gw = F.vcu * NWAVES + F.wave, NGW = F.G * NWAVES;
    unsigned char* ws = F.ws;
    constexpr int I0 = 16 * 32, I1 = 16 * 16, I2 = 16 * 14, I3 = 16 * 16, I4 = 64 * 128, I5 = 64 * 64, I6 = 2 * 64, I7 = 2 * 256;
    constexpr int NIT = I0 + I1 + I2 + I3 + I4 + I5 + I6 + I7;
    for (int it = gw; it < NIT; it += NGW) {
        int r = it;
        if (r < I0) { const int kb = r / 32, nb = r % 32; cvt_t_item(args.in[2], 2048, kb * 64, nb * 64, 2048, (bf16*)(ws + WS_WA_IN), 1024, nb * 64, scr, ((int)threadIdx.x & 63)); continue; } r -= I0;
        if (r < I1) { const int kb = r / 16, nb = r % 16; cvt_t_item(args.in[8], 1024, kb * 64, nb * 64, 1024, (bf16*)(ws + WS_WA_OUT), 1024, nb * 64, scr, ((int)threadIdx.x & 63)); continue; } r -= I1;
        if (r < I2) { const int kb = r / 14, nb = r % 14; cvt_t_item(args.in[9] + 1024, PROJ_B, kb * 64, nb * 64, PROJ_B - 1024, (bf16*)(ws + WS_WB_IN), 1024, 2048 + nb * 64, scr, ((int)threadIdx.x & 63)); continue; } r -= I2;
        if (r < I3) { const int kb = r / 16, nb = r % 16; cvt_t_item(args.in[13], 1024, kb * 64, nb * 64, 1024, (bf16*)(ws + WS_WBOUT), 1024, nb * 64, scr, ((int)threadIdx.x & 63)); continue; } r -= I3;
        if (r < I4) { const int e = r / 128, q = r % 128, kb = q / 8, nb = q % 8; const int n0 = nb * 64, half = n0 >> 8, rem = n0 & 255, pn = rem >> 7, j0 = rem & 127;
            if (e >= 32) continue;
            cvt_t_item(args.in[22] + (size_t)e * 1024 * 512, 512, kb * 64, n0, 512, (bf16*)(ws + WS_WE_IN) + (size_t)e * 512 * 1024, 1024, pn * 256 + half * 128 + j0, scr, ((int)threadIdx.x & 63)); continue; } r -= I4;
        if (r < I5) { const int e = r / 64, q = r % 64, kb = q / 16, nb = q % 16;
            if (e >= 32) continue;
            cvt_t_item(args.in[23] + (size_t)e * 256 * 1024, 1024, kb * 64, nb * 64, 1024, (bf16*)(ws + WS_WE_OUT) + (size_t)e * 1024 * 256, 256, nb * 64, scr, ((int)threadIdx.x & 63)); continue; } r -= I5;
        if (r < I6) { const int l = r / 64, q = r % 64, kb = q / 16, nb = q % 16;
            if (l >= 1) continue;
            cvt_t_item(args.in[24] + (size_t)l * 256 * 1024, 1024, kb * 64, nb * 64, 1024, (bf16*)(ws + WS_WP) + (size_t)l * 1024 * 256, 256, nb * 64, scr, ((int)threadIdx.x & 63)); continue; } r -= I6;
        { const int l = r / 256, q = r % 256, kb = q / 16, nb = q % 16;
            if (l >= 1) continue;
            cvt_t_item(args.in[25] + (size_t)l * 1024 * 1024, 1024, kb * 64, nb * 64, 1024, (bf16*)(ws + WS_WG) + (size_t)l * 1024 * 1024, 1024, nb * 64, scr, ((int)threadIdx.x & 63)); }
    }
    cvt_rows(args.in[0], 1024, (bf16*)(ws + WS_A), 1024, T, 1024, gw, NGW, ((int)threadIdx.x & 63));
    cvt_rows(args.in[1], 256, (bf16*)(ws + WS_PB), 256, 2 * T, 256, gw, NGW, ((int)threadIdx.x & 63));
    cvt_rows(args.in[11], 128, (bf16*)(ws + WS_WUK), 128, 8 * 256, 128, gw, NGW, ((int)threadIdx.x & 63));
    cvt_rows(args.in[12], 128, (bf16*)(ws + WS_WUV), 128, 8 * 256, 128, gw, NGW, ((int)threadIdx.x & 63));
    cvt_rows(args.in[9], PROJ_B, (bf16*)(ws + WS_WBQ), 1024, 1024, 1024, gw, NGW, ((int)threadIdx.x & 63));
    { float* RWT = (float*)(ws + WS_RWT);
      for (int i = gw * 64 + ((int)threadIdx.x & 63); i < 2 * 36 * 1024; i += NGW * 64) { const int L = i / (36 * 1024), j = (i / 1024) % 36, c = i % 1024;
          RWT[i] = (j < 4) ? args.in[18][(size_t)L * 4096 + c * 4 + j] : args.in[20][(size_t)L * 32768 + c * 32 + (j - 4)]; } }
    { v4u z = {0u, 0u, 0u, 0u}; v4u* d = (v4u*)((bf16*)(ws + WS_WB_IN) + (size_t)2944 * 1024);
      for (int i = gw * 64 + ((int)threadIdx.x & 63); i < 128 * 1024 / 8; i += NGW * 64) d[i] = z; }
}


__device__ __forceinline__ void cvt_late(Frame& F, const Args& args, int slot, int nslots) {
    LAS float* scr = (LAS float*)(F.lds + F.wave * 16640); unsigned char* ws = F.ws; const int lane = ((int)threadIdx.x & 63);
    for (int it = slot; it < 32 * 128 + 32 * 64 + 64 + 256; it += nslots) {
        if (it < 32 * 128) { const int e = 32 + it / 128, q = it % 128, kb = q / 8, nb = q % 8; const int n0 = nb * 64, half = n0 >> 8, rem = n0 & 255, pn = rem >> 7, j0 = rem & 127;
            cvt_t_item(args.in[22] + (size_t)e * 1024 * 512, 512, kb * 64, n0, 512, (bf16*)(ws + WS_WE_IN) + (size_t)e * 512 * 1024, 1024, pn * 256 + half * 128 + j0, scr, lane); }
        else if (it < 32 * 128 + 32 * 64) { const int r = it - 32 * 128; const int e = 32 + r / 64, q = r % 64, kb = q / 16, nb = q % 16;
            cvt_t_item(args.in[23] + (size_t)e * 256 * 1024, 1024, kb * 64, nb * 64, 1024, (bf16*)(ws + WS_WE_OUT) + (size_t)e * 1024 * 256, 256, nb * 64, scr, lane); }
        else if (it < 32 * 128 + 32 * 64 + 64) { const int q = it - (32 * 128 + 32 * 64), kb = q / 16, nb = q % 16;
            cvt_t_item(args.in[24] + (size_t)256 * 1024, 1024, kb * 64, nb * 64, 1024, (bf16*)(ws + WS_WP) + (size_t)1024 * 256, 256, nb * 64, scr, lane); }
        else { const int q = it - (32 * 128 + 32 * 64 + 64), kb = q / 16, nb = q % 16;
            cvt_t_item(args.in[25] + (size_t)1024 * 1024, 1024, kb * 64, nb * 64, 1024, (bf16*)(ws + WS_WG) + (size_t)1024 * 1024, 1024, nb * 64, scr, lane); }
    }

}

__device__ __forceinline__ unsigned off_b(unsigned row, unsigned ch) { return 256u * row + 16u * (ch ^ (((row & 3) << 2) | ((row >> 2) & 3))); }
__device__ __forceinline__ unsigned row_read_addr_16(unsigned lane, unsigned rb, unsigned s) { return off_b((lane & 15) + 16 * rb, 4 * s + (lane >> 4)); }
__device__ __forceinline__ unsigned tr_read_addr_16(unsigned lane, unsigned c, unsigned ks, unsigned t) {
    const unsigned g = lane >> 4, q = (lane & 15) >> 2, p = lane & 3;
    return off_b(32 * ks + 8 * g + 4 * t + q, 2 * c + (p >> 1)) + 8 * (p & 1);
}
__device__ __forceinline__ bf16x4 tr_read(LAS unsigned char* p) { return __builtin_amdgcn_ds_read_tr16_b64_v4i16((LAS bf16x4*)p); }
__device__ __forceinline__ float wave_sum(float v) {
#pragma unroll
    for (int o = 1; o < 64; o <<= 1) v += __shfl_xor(v, o);
    return v;
}


__device__ __forceinline__ float dpp_xor1(float x) { return __int_as_float(__builtin_amdgcn_update_dpp(0, __float_as_int(x), 0xB1, 0xf, 0xf, true)); }
__device__ __forceinline__ float dpp_xor2(float x) { return __int_as_float(__builtin_amdgcn_update_dpp(0, __float_as_int(x), 0x4E, 0xf, 0xf, true)); }
__device__ __forceinline__ float dpp_xor4(float x, bool b2) { const float up = __int_as_float(__builtin_amdgcn_update_dpp(0, __float_as_int(x), 0x104, 0xf, 0xf, true)),
        dn = __int_as_float(__builtin_amdgcn_update_dpp(0, __float_as_int(x), 0x114, 0xf, 0xf, true)); return b2 ? dn : up; }
__device__ __forceinline__ float dpp_xor8(float x) { return __int_as_float(__builtin_amdgcn_update_dpp(0, __float_as_int(x), 0x128, 0xf, 0xf, true)); }
__device__ __forceinline__ float xg_max(float x) {
    auto r = __builtin_amdgcn_permlane16_swap(__float_as_uint(x), __float_as_uint(x), false, false); x = fmaxf(__uint_as_float(r[0]), __uint_as_float(r[1]));
    auto q = __builtin_amdgcn_permlane32_swap(__float_as_uint(x), __float_as_uint(x), false, false); return fmaxf(__uint_as_float(q[0]), __uint_as_float(q[1]));
}
__device__ __forceinline__ float xg_sum(float x) {
    auto r = __builtin_amdgcn_permlane16_swap(__float_as_uint(x), __float_as_uint(x), false, false); x = __uint_as_float(r[0]) + __uint_as_float(r[1]);
    auto q = __builtin_amdgcn_permlane32_swap(__float_as_uint(x), __float_as_uint(x), false, false); return __uint_as_float(q[0]) + __uint_as_float(q[1]);
}
__device__ __forceinline__ float wave_sum_fast(float v) { v += dpp_xor1(v); v += dpp_xor2(v); v += dpp_xor4(v, ((int)threadIdx.x & 4) != 0); v += dpp_xor8(v); return xg_sum(v); }

__device__ __forceinline__ void p2_spatial(Frame& F, const Args& args) {
    unsigned char* ws = F.ws;
    const bf16* UV = (const bf16*)(ws + WS_B); bf16* GT = (bf16*)(ws + WS_A);
    const float* vn_g = args.in[4]; const float* vn_b = args.in[5]; const float* w_s = args.in[6]; const float* b_s = args.in[7];
    LAS unsigned char* VIMG = F.lds; LAS unsigned char* WIMG = F.lds + 32768; LAS f32x2* STATS = (LAS f32x2*)(F.lds + 65536); LAS float* RS = (LAS float*)(F.lds + 65536 + 1024);
    const int lane = ((int)threadIdx.x & 63), w = F.wave, tid = ((int)threadIdx.x);
    const int srow = tid >> 2, q4 = tid & 3;
    for (int unit = F.vcu; unit < 256; unit += F.G) {
        const int chunk = unit >> 1, half = unit & 1; const size_t t0 = (size_t)chunk * 128;
        { v4u ra[16], rb[16];
#pragma unroll
          for (int r = 0; r < 16; ++r) { const v4u* vp = (const v4u*)(UV + (t0 + 16 * w + r) * 2048 + 1024 + lane * 16); ra[r] = vp[0]; rb[r] = vp[1]; }
#pragma unroll
          for (int r = 0; r < 16; ++r) { float s = 0.f, q = 0.f;
#pragma unroll
              for (int e = 0; e < 4; ++e) { const float x0 = bflo(ra[r][e]), x1 = bfhi(ra[r][e]), x2 = bflo(rb[r][e]), x3 = bfhi(rb[r][e]); s += (x0 + x1) + (x2 + x3); q += (x0 * x0 + x1 * x1) + (x2 * x2 + x3 * x3); }
              s = wave_sum_fast(s); q = wave_sum_fast(q);
              const float mean = s * (1.f / 1024.f); const float var = fmaxf(q * (1.f / 1024.f) - mean * mean, 0.f);
              if (lane == 0) STATS[16 * w + r] = (f32x2){mean, rsqrtf(var + 1e-5f)}; } }
        v4u va[4]; f32x4 wa[4], wb[4];
#define P2_RAW(g_) do { _Pragma("unroll") for (int c4 = 0; c4 < 4; ++c4) { const int ch_ = 4 * q4 + c4; va[c4] = *(const v4u*)(UV + (t0 + srow) * 2048 + 1024 + (g_) * 128 + 8 * ch_); \
            const float* wp_ = w_s + ((size_t)(g_) * 128 + srow) * 128 + 8 * ch_; wa[c4] = *(const f32x4*)wp_; wb[c4] = *(const f32x4*)(wp_ + 4); } } while (0)
        P2_RAW(half * 4);
        __syncthreads();
        for (int gi = 0; gi < 4; ++gi) {
            const int g = half * 4 + gi;
            { const f32x2 st = STATS[srow]; float wsum = 0.f;
#pragma unroll
              for (int c4 = 0; c4 < 4; ++c4) { const int ch = 4 * q4 + c4; const v4u a = va[c4];
                  v4u o;
                  o.x = pk2((bflo(a.x) - st.x) * st.y, (bfhi(a.x) - st.x) * st.y); o.y = pk2((bflo(a.y) - st.x) * st.y, (bfhi(a.y) - st.x) * st.y);
                  o.z = pk2((bflo(a.z) - st.x) * st.y, (bfhi(a.z) - st.x) * st.y); o.w = pk2((bflo(a.w) - st.x) * st.y, (bfhi(a.w) - st.x) * st.y);
                  *(LAS v4u*)(VIMG + off_b(srow, ch)) = o;
                  const int s0 = 8 * ch; float m[8];
#pragma unroll
                  for (int e = 0; e < 4; ++e) { m[e] = (s0 + e <= srow) ? wa[c4][e] : 0.f; m[4 + e] = (s0 + 4 + e <= srow) ? wb[c4][e] : 0.f; }
                  v4u ow; ow.x = pk2(m[0], m[1]); ow.y = pk2(m[2], m[3]); ow.z = pk2(m[4], m[5]); ow.w = pk2(m[6], m[7]);
                  wsum += (bflo(ow.x) + bfhi(ow.x)) + (bflo(ow.y) + bfhi(ow.y)) + (bflo(ow.z) + bfhi(ow.z)) + (bflo(ow.w) + bfhi(ow.w));
                  *(LAS v4u*)(WIMG + off_b(srow, ch)) = ow; }
              wsum += dpp_xor1(wsum); wsum += dpp_xor2(wsum);
              if (q4 == 0) RS[srow] = wsum; }
            __syncthreads();
            if (gi < 3) P2_RAW(g + 1);
            const int wd = w >> 1, wt = w & 1;
            v2u uu[4][2]; float bs[4], rsv[4]; f32x4 gd[2], bd[2];
#pragma unroll
            for (int dt = 0; dt < 2; ++dt) { const int dcol = g * 128 + 32 * wd + 16 * dt + 4 * (lane >> 4); gd[dt] = *(const f32x4*)(vn_g + dcol); bd[dt] = *(const f32x4*)(vn_b + dcol); }
#pragma unroll
            for (int tb = 0; tb < 4; ++tb) { const int tl = 64 * wt + 16 * tb + (lane & 15); bs[tb] = b_s[g * 128 + tl]; rsv[tb] = RS[tl];
#pragma unroll
                for (int dt = 0; dt < 2; ++dt) uu[tb][dt] = *(const v2u*)(UV + (t0 + tl) * 2048 + g * 128 + 32 * wd + 16 * dt + 4 * (lane >> 4)); }
            f32x4 acc[2][4];
#pragma unroll
            for (int i = 0; i < 2; ++i)
#pragma unroll
                for (int j = 0; j < 4; ++j) acc[i][j] = (f32x4){0.f, 0.f, 0.f, 0.f};
            const int nks = wt ? 4 : 2;
            for (int ks = 0; ks < nks; ++ks) {
                bf16x8 Af[2], Bf[4];
#pragma unroll
                for (int dt = 0; dt < 2; ++dt) { const bf16x4 lo = tr_read(VIMG + tr_read_addr_16(lane, 2 * wd + dt, ks, 0)), hi = tr_read(VIMG + tr_read_addr_16(lane, 2 * wd + dt, ks, 1));
                    Af[dt] = (bf16x8){lo[0], lo[1], lo[2], lo[3], hi[0], hi[1], hi[2], hi[3]}; }
#pragma unroll
                for (int tb = 0; tb < 4; ++tb) Bf[tb] = *(const LAS bf16x8*)(WIMG + row_read_addr_16(lane, 4 * wt + tb, ks));
#pragma unroll
                for (int dt = 0; dt < 2; ++dt)
#pragma unroll
                    for (int tb = 0; tb < 4; ++tb) acc[dt][tb] = __builtin_amdgcn_mfma_f32_16x16x32_bf16(Af[dt], Bf[tb], acc[dt][tb], 0, 0, 0);
            }
#pragma unroll
            for (int tb = 0; tb < 4; ++tb) { const size_t t = t0 + 64 * wt + 16 * tb + (lane & 15);
#pragma unroll
                for (int dt = 0; dt < 2; ++dt) { const int dcol = g * 128 + 32 * wd + 16 * dt + 4 * (lane >> 4); const v2u u = uu[tb][dt];
                    const f32x4 sv = acc[dt][tb] * gd[dt] + bd[dt] * rsv[tb] + bs[tb];
                    v2u o; o.x = pk2(bflo(u.x) * sv[0], bfhi(u.x) * sv[1]); o.y = pk2(bflo(u.y) * sv[2], bfhi(u.y) * sv[3]);
                    *(v2u*)(GT + t * 1024 + dcol) = o; } }
            __syncthreads();
        }
#undef P2_RAW
    }
}


struct MoeTab { LAS int* tpre; LAS int* cnt; LAS int* tile_e; LAS int* nt; };
__device__ __forceinline__ MoeTab moe_tab(Frame& F) { LAS int* b = (LAS int*)(F.lds + XTRA_OFF); MoeTab t; t.tpre = b; t.cnt = b + 64; t.tile_e = b + 128; t.nt = b + 320; return t; }
__device__ __forceinline__ void moe_tab_build(Frame& F, int L) {
    MoeTab t = moe_tab(F); const unsigned* counts = (const unsigned*)(F.ws + WS_CTL) + CW_COUNTS + 32 * L;
    __syncthreads();
    if (((int)threadIdx.x) < 32) t.cnt[((int)threadIdx.x)] = (int)__hip_atomic_load(counts + ((int)threadIdx.x), __ATOMIC_RELAXED, __HIP_MEMORY_SCOPE_AGENT);
    __syncthreads();
    if (((int)threadIdx.x) == 0) { int p = 0; for (int e = 0; e < 32; ++e) { t.tpre[e] = p; p += (t.cnt[e] + 255) >> 8; } t.tpre[32] = p; t.nt[0] = p; }
    __syncthreads();
    const int nt = t.nt[0];
    for (int m = ((int)threadIdx.x); m < nt; m += NWAVES * 64) { int e = 0; while (e < 31 && m >= t.tpre[e + 1]) ++e; t.tile_e[m] = e; }
    __syncthreads();
}

__device__ __forceinline__ void p4_ln_router(Frame& F, const Args& args, int L, const bf16* R, bf16* X1b) {
    unsigned char* ws = F.ws;
    const float* lng = args.in[14] + L * 1024; const float* lnb = args.in[15] + L * 1024;
    const float* bg = args.in[19] + L * 4; const float* be = args.in[21] + L * 32;
    const float* RWT = (const float*)(ws + WS_RWT) + (size_t)L * 36 * 1024;
    unsigned* gcount = (unsigned*)(ws + WS_CTL) + CW_COUNTS + 32 * L;
    int* LIST = (int*)(ws + WS_LIST); float* GLIST = (float*)(ws + WS_GLIST); int* TOK2 = (int*)(ws + WS_TOK2);
    const int lane = ((int)threadIdx.x & 63), w = F.wave, tid = ((int)threadIdx.x);
    LAS float* LG = (LAS float*)(F.lds) + w * (8 * 40);
    LAS float* PE = (LAS float*)(F.lds + 16384) + w * 64;
    LAS int* RT_E = (LAS int*)(F.lds + 32768);
    LAS float* RT_G = (LAS float*)(F.lds + 32768 + 1024);
    LAS int* RT_P = (LAS int*)(F.lds + 32768 + 2048);
    LAS int* LCNT = (LAS int*)(F.lds + 32768 + 4096);
    LAS int* LBASE = (LAS int*)(F.lds + 32768 + 4096 + 256);
    for (int blk = F.vcu; blk < T / 64; blk += F.G) {
        const int rbase = blk * 64 + w * 8;
        f32x4 xv[8][4];
        { v2u rb[8][4]; f32x4 gg[4], bb[4];
#pragma unroll
          for (int r = 0; r < 8; ++r)
#pragma unroll
              for (int i = 0; i < 4; ++i) rb[r][i] = *(const v2u*)(R + (size_t)(rbase + r) * 1024 + 4 * lane + 256 * i);
#pragma unroll
          for (int i = 0; i < 4; ++i) { gg[i] = *(const f32x4*)(lng + 4 * lane + 256 * i); bb[i] = *(const f32x4*)(lnb + 4 * lane + 256 * i); }
#pragma unroll
          for (int r = 0; r < 8; ++r) { float s = 0.f;
#pragma unroll
              for (int i = 0; i < 4; ++i) { xv[r][i] = (f32x4){bflo(rb[r][i].x), bfhi(rb[r][i].x), bflo(rb[r][i].y), bfhi(rb[r][i].y)}; s += (xv[r][i][0] + xv[r][i][1]) + (xv[r][i][2] + xv[r][i][3]); }
              const float mean = wave_sum_fast(s) * (1.f / 1024.f); float q = 0.f;
#pragma unroll
              for (int i = 0; i < 4; ++i) { xv[r][i] = xv[r][i] - mean; q += (xv[r][i][0] * xv[r][i][0] + xv[r][i][1] * xv[r][i][1]) + (xv[r][i][2] * xv[r][i][2] + xv[r][i][3] * xv[r][i][3]); }
              const float rstd = rsqrtf(wave_sum_fast(q) * (1.f / 1024.f) + 1e-5f);
#pragma unroll
              for (int i = 0; i < 4; ++i) { xv[r][i] = xv[r][i] * rstd * gg[i] + bb[i];
                  v2u o; o.x = pk2(xv[r][i][0], xv[r][i][1]); o.y = pk2(xv[r][i][2], xv[r][i][3]);
                  *(v2u*)(X1b + (size_t)(rbase + r) * 1024 + 4 * lane + 256 * i) = o; } } }
        f32x4 wn[4];
#pragma unroll
        for (int i = 0; i < 4; ++i) wn[i] = *(const f32x4*)(RWT + 4 * lane + 256 * i);
        for (int j = 0; j < 36 * (1 + P4_DUP_ROUTER); ++j) { if (P4_DUP_ROUTER && j == 36) { _Pragma("unroll") for (int i = 0; i < 4; ++i) wn[i] = *(const f32x4*)(RWT + 4 * lane + 256 * i); }
            f32x4 wv[4];
#pragma unroll
            for (int i = 0; i < 4; ++i) wv[i] = wn[i];
            { const int jj_ = j % 36; const float* wp = RWT + (size_t)(jj_ < 35 ? jj_ + 1 : 35) * 1024 + 4 * lane;
#pragma unroll
              for (int i = 0; i < 4; ++i) wn[i] = *(const f32x4*)(wp + 256 * i); }
            float v[8];
#pragma unroll
            for (int r = 0; r < 8; ++r) { f32x2 a2 = {0.f, 0.f};
#pragma unroll
                for (int i = 0; i < 4; ++i) { a2 = __builtin_elementwise_fma((f32x2){xv[r][i][0], xv[r][i][1]}, (f32x2){wv[i][0], wv[i][1]}, a2); a2 = __builtin_elementwise_fma((f32x2){xv[r][i][2], xv[r][i][3]}, (f32x2){wv[i][2], wv[i][3]}, a2); }
                v[r] = a2.x + a2.y; }
            const bool b0 = lane & 1, b1 = lane & 2, b2 = lane & 4;
            float n1[4];
#pragma unroll
            for (int k = 0; k < 4; ++k) { const float keep = b0 ? v[2 * k + 1] : v[2 * k], send = b0 ? v[2 * k] : v[2 * k + 1]; n1[k] = keep + dpp_xor1(send); }
            float n2[2];
#pragma unroll
            for (int m = 0; m < 2; ++m) { const float keep = b1 ? n1[2 * m + 1] : n1[2 * m], send = b1 ? n1[2 * m] : n1[2 * m + 1]; n2[m] = keep + dpp_xor2(send); }
            float n3; { const float keep = b2 ? n2[1] : n2[0], send = b2 ? n2[0] : n2[1]; n3 = keep + dpp_xor4(send, b2); }
            n3 += dpp_xor8(n3); n3 = xg_sum(n3);
            if (lane < 8) LG[lane * 40 + (j % 36)] = n3;
        }
        LDS_WAIT();
        if (lane < 8) {
            LAS float* lg = LG + lane * 40; LAS float* pe = PE + lane * 8;
            int gs = 0; float gm = lg[0] + bg[0];
            for (int j = 1; j < 4; ++j) { const float v = lg[j] + bg[j]; if (v > gm) { gm = v; gs = j; } }
            float gsum = 0.f; for (int j = 0; j < 4; ++j) gsum += expf(lg[j] + bg[j] - gm);
            const float pg = 1.f / gsum;
            float em = -1e30f; for (int j = 0; j < 8; ++j) { const float v = lg[4 + gs * 8 + j] + be[gs * 8 + j]; pe[j] = v; em = fmaxf(em, v); }
            float es = 0.f; for (int j = 0; j < 8; ++j) { const float v = expf(pe[j] - em); pe[j] = v; es += v; }
            for (int j = 0; j < 8; ++j) pe[j] = pe[j] / es;
            int i0 = 0; float p0 = pe[0]; for (int j = 1; j < 8; ++j) if (pe[j] > p0) { p0 = pe[j]; i0 = j; }
            int i1 = (i0 == 0) ? 1 : 0; float p1 = pe[i1]; for (int j = 0; j < 8; ++j) if (j != i0 && pe[j] > p1) { p1 = pe[j]; i1 = j; }
            const float sp = p0 + p1; const int rr = w * 8 + lane;
            RT_E[rr * 2 + 0] = gs * 8 + i0; RT_E[rr * 2 + 1] = gs * 8 + i1; RT_G[rr * 2 + 0] = p0 / sp * pg; RT_G[rr * 2 + 1] = p1 / sp * pg;
        }
        if (args.pad != 0) { __syncthreads(); continue; }
        if (tid < 32) LCNT[tid] = 0;
        __syncthreads();
        if (tid < 128) RT_P[tid] = atomicAdd((int*)&LCNT[RT_E[tid]], 1);
        __syncthreads();
        if (tid < 32) { const int c = LCNT[tid]; LBASE[tid] = c ? (int)__hip_atomic_fetch_add(gcount + tid, (unsigned)c, __ATOMIC_RELAXED, __HIP_MEMORY_SCOPE_AGENT) : 0; }
        __syncthreads();
        if (tid < 128) { const int e = RT_E[tid], pos = LBASE[e] + RT_P[tid], tok = blk * 64 + (tid >> 1);
            LIST[e * 16384 + pos] = tok; GLIST[e * 16384 + pos] = RT_G[tid]; TOK2[tok * 2 + (tid & 1)] = (e << 16) | pos; }
        __syncthreads();
    }
}

struct MoeSched1 {
    MoeTab t; int G, c; const char* A; const char* W; const int* LIST;
    __device__ bool next(int i, pg8::Unit& u) const {
        const int nt = __builtin_amdgcn_readfirstlane(t.nt[0]); const int idx = i * G + c; if (idx >= 2 * nt) return false;
        const int mt = idx >> 1, pn = idx & 1; const int e = __builtin_amdgcn_readfirstlane(t.tile_e[mt]); const int m_in = mt - __builtin_amdgcn_readfirstlane(t.tpre[e]);
        const int left = __builtin_amdgcn_readfirstlane(t.cnt[e]) - 256 * m_in;
        u.a = A; u.b = W + ((size_t)e * 512 + 256 * pn) * 1024 * 2; u.row0 = 256 * mt; u.col0 = 128 * pn; u.aux = e * 16384 + 256 * m_in; u.rows = LIST + e * 16384 + 256 * m_in; u.nrows = left < 256 ? left : 256; return true;
    }
    __device__ __forceinline__ void ready(const pg8::Unit&) const {}
    __device__ __forceinline__ void ready_first(const pg8::Unit&) const {}
    __device__ __forceinline__ void done(const pg8::Unit&) const {}
};
struct EpiMoe1 {
    static constexpr bool PERM = true;
    bf16* H; const float* GLIST;
    __device__ __forceinline__ void operator()(const f32x4 (&acc)[2][2][4][2], const pg8::Unit& u, int wr, int wc, int fr, int fq) const {
        const int col = u.col0 + wc * 32 + 8 * fq;
#pragma unroll
        for (int ai = 0; ai < 2; ++ai)
#pragma unroll
            for (int m = 0; m < 4; ++m) { const int rl = ai * 128 + wr * 64 + m * 16 + fr; const float gt = (rl < u.nrows) ? GLIST[u.aux + rl] : 0.f;
                float h[8];
#pragma unroll
                for (int n = 0; n < 2; ++n)
#pragma unroll
                    for (int i = 0; i < 4; ++i) { const float a = acc[ai][0][m][n][i], b = acc[ai][1][m][n][i]; h[4 * n + i] = a * __builtin_amdgcn_rcpf(1.f + __builtin_amdgcn_exp2f(-1.4426950408889634f * a)) * b * gt; }
                v4u o; o.x = pg8::cvt_pk_bf16(h[0], h[1]); o.y = pg8::cvt_pk_bf16(h[2], h[3]); o.z = pg8::cvt_pk_bf16(h[4], h[5]); o.w = pg8::cvt_pk_bf16(h[6], h[7]);
                *(v4u*)(H + (size_t)(u.row0 + rl) * 256 + col) = o; }
    }
};
struct MoeSched2 {
    MoeTab t; int G, c; const char* Hb; const char* W;
    __device__ bool next(int i, pg8::Unit& u) const {
        const int nt = __builtin_amdgcn_readfirstlane(t.nt[0]); const int idx = i * G + c; if (idx >= 4 * nt) return false;
        const int mt = idx >> 2, pn = idx & 3; const int e = __builtin_amdgcn_readfirstlane(t.tile_e[mt]);
        u.a = Hb + (size_t)mt * 256 * 256 * 2; u.b = W + ((size_t)e * 1024 + 256 * pn) * 256 * 2; u.row0 = 256 * mt; u.col0 = 256 * pn; u.aux = 0; u.rows = nullptr; u.nrows = 256; return true;
    }
    __device__ __forceinline__ void ready(const pg8::Unit&) const {}
    __device__ __forceinline__ void ready_first(const pg8::Unit&) const {}
    __device__ __forceinline__ void done(const pg8::Unit&) const {}
};

struct PwSched {
    LAS int* tb; int G, c; const char* A; const char* Bt;
    __device__ bool next(int i, pg8::Unit& u) const {
        const int nt = __builtin_amdgcn_readfirstlane(tb[320]); int nheavy = 2 * nt - G; nheavy = nheavy < 0 ? 0 : (nheavy > G / 2 ? G / 2 : nheavy);
        if (c < nheavy) return false; const int idx = i * (G - nheavy) + (c - nheavy); if (idx >= (T / 256) * 4) return false;
        const int pm = idx >> 2, pn = idx & 3;
        u.a = A + (size_t)pm * 256 * 256 * 2; u.b = Bt + (size_t)pn * 256 * 256 * 2; u.row0 = pm * 256; u.col0 = pn * 256; u.aux = 0; u.rows = nullptr; u.nrows = 256; return true;
    }
    __device__ __forceinline__ void ready(const pg8::Unit&) const {}
    __device__ __forceinline__ void ready_first(const pg8::Unit&) const {}
    __device__ __forceinline__ void done(const pg8::Unit&) const {}
};

__device__ __forceinline__ void p7_ln2(Frame& F, const Args& args, int L, const bf16* X1b, const bf16* Y, bf16* X2b) {
    MoeTab t = moe_tab(F);
    const float* lng = args.in[16] + L * 1024; const float* lnb = args.in[17] + L * 1024; const int* TOK2 = (const int*)(F.ws + WS_TOK2);
    const int lane = ((int)threadIdx.x & 63);
    const int stride = F.G * NWAVES;
    for (int row0 = F.vcu * NWAVES + F.wave; row0 < T; row0 += 4 * stride) {
        int rows[4]; size_t s0[4], s1[4];
#pragma unroll
        for (int u = 0; u < 4; ++u) { rows[u] = row0 + u * stride < T ? row0 + u * stride : row0; const int k0 = TOK2[rows[u] * 2], k1 = TOK2[rows[u] * 2 + 1];
            s0[u] = (size_t)256 * t.tpre[k0 >> 16] + (k0 & 0xffff); s1[u] = (size_t)256 * t.tpre[k1 >> 16] + (k1 & 0xffff); }
        v2u xb[4][4], ya[4][4], yb[4][4];
#pragma unroll
        for (int u = 0; u < 4; ++u)
#pragma unroll
            for (int i = 0; i < 4; ++i) { const int c = 4 * lane + 256 * i; xb[u][i] = *(const v2u*)(X1b + (size_t)rows[u] * 1024 + c); ya[u][i] = *(const v2u*)(Y + s0[u] * 1024 + c); yb[u][i] = *(const v2u*)(Y + s1[u] * 1024 + c); }
#pragma unroll
        for (int u = 0; u < 4; ++u) {
            f32x4 v[4]; float s = 0.f;
#pragma unroll
            for (int i = 0; i < 4; ++i) { const v2u x = xb[u][i], a = ya[u][i], b = yb[u][i];
                v[i][0] = ALPHA * bflo(x.x) + (bflo(a.x) + bflo(b.x)); v[i][1] = ALPHA * bfhi(x.x) + (bfhi(a.x) + bfhi(b.x)); v[i][2] = ALPHA * bflo(x.y) + (bflo(a.y) + bflo(b.y)); v[i][3] = ALPHA * bfhi(x.y) + (bfhi(a.y) + bfhi(b.y));
                s += (v[i][0] + v[i][1]) + (v[i][2] + v[i][3]); }
            const float mean = wave_sum_fast(s) * (1.f / 1024.f); float q = 0.f;
#pragma unroll
            for (int i = 0; i < 4; ++i) { v[i] = v[i] - mean; q += (v[i][0] * v[i][0] + v[i][1] * v[i][1]) + (v[i][2] * v[i][2] + v[i][3] * v[i][3]); }
            const float rstd = rsqrtf(wave_sum_fast(q) * (1.f / 1024.f) + 1e-5f);
            if (row0 + u * stride < T) {
#pragma unroll
                for (int i = 0; i < 4; ++i) { const int c = 4 * lane + 256 * i; const f32x4 gg = *(const f32x4*)(lng + c), bb = *(const f32x4*)(lnb + c);
                    const f32x4 o = v[i] * rstd * gg + bb;
                    v2u ob; ob.x = pk2(o[0], o[1]); ob.y = pk2(o[2], o[3]); *(v2u*)(X2b + (size_t)rows[u] * 1024 + c) = ob; } }
        }
    }
}


struct EpiPle {
    static constexpr bool PERM = true;
    const bf16* X2b; const bf16* PW; const float* gb; float* outf; bf16* outb;
    __device__ __forceinline__ void operator()(const f32x4 (&acc)[2][2][4][2], const pg8::Unit& u, int wr, int wc, int fr, int fq) const {
        const int col0 = u.col0 + wc * 32 + 8 * fq;
#pragma unroll
        for (int ai = 0; ai < 2; ++ai)
#pragma unroll
            for (int m = 0; m < 4; ++m) { const size_t rowoff = (size_t)(u.row0 + wr * 64 + fr + ai * 128 + m * 16) * 1024;
#pragma unroll
                for (int bj = 0; bj < 2; ++bj)
#pragma unroll
                    for (int n = 0; n < 2; ++n) { const int c = col0 + bj * 128 + 4 * n; const v2u pw = *(const v2u*)(PW + rowoff + c);
                        const v2u xb = *(const v2u*)(X2b + rowoff + c); const f32x4 x0 = (f32x4){bflo(xb.x), bfhi(xb.x), bflo(xb.y), bfhi(xb.y)}, g0 = *(const f32x4*)(gb + c);
                        const f32x4 z0 = acc[ai][bj][m][n] + g0; f32x4 o0;
                        o0[0] = x0[0] + bflo(pw.x) * __builtin_amdgcn_rcpf(1.f + __builtin_amdgcn_exp2f(-1.4426950408889634f * z0[0]));
                        o0[1] = x0[1] + bfhi(pw.x) * __builtin_amdgcn_rcpf(1.f + __builtin_amdgcn_exp2f(-1.4426950408889634f * z0[1]));
                        o0[2] = x0[2] + bflo(pw.y) * __builtin_amdgcn_rcpf(1.f + __builtin_amdgcn_exp2f(-1.4426950408889634f * z0[2]));
                        o0[3] = x0[3] + bfhi(pw.y) * __builtin_amdgcn_rcpf(1.f + __builtin_amdgcn_exp2f(-1.4426950408889634f * z0[3]));
                        if (outf) *(f32x4*)(outf + rowoff + c) = o0;
                        if (outb) { v2u w; w.x = pg8::cvt_pk_bf16(o0[0], o0[1]); w.y = pg8::cvt_pk_bf16(o0[2], o0[3]); *(v2u*)(outb + rowoff + c) = w; } }
                if (m == 3) asm volatile("" ::: "memory"); }
    }
};
__device__ __forceinline__ void p8_ple(Frame& F, const Args& args, int L, const bf16* X2b, bf16* PW, float* outf, bf16* outb) {
    unsigned char* ws = F.ws;
    { pg8::Gemm g{1024, 1024, 1024}; pg8::StaticOrder S; S.init(T, 1024, F.G, (int)blockIdx.x, X2b, ws + WS_WG + (size_t)L * 1024 * 1024 * 2, 1024, 1024);
      EpiPle E{X2b, PW, args.in[26] + L * 1024, outf, outb};
      pg8::gemm_phase<EpiPle, pg8::StaticOrder, false>(F.lds, g, S, E); }
}


struct WqlatSched {
    int G, c; const char* wuk; const char* wbq;
    __device__ bool next(int i, pg8::Unit& u) const { const int idx = i * G + c; if (idx >= 32) return false; const int h = idx >> 2, pn = idx & 3;
        u.a = wuk + (size_t)h * 256 * 128 * 2; u.b = wbq + ((size_t)pn * 256 * 1024 + h * 128) * 2; u.row0 = h * 256; u.col0 = pn * 256; u.aux = 0; u.rows = nullptr; u.nrows = 256; return true; }
    __device__ __forceinline__ void ready(const pg8::Unit&) const {}
    __device__ __forceinline__ void ready_first(const pg8::Unit&) const {}
    __device__ __forceinline__ void done(const pg8::Unit&) const {}
};
struct WcombSched {
    int G, c; const char* wbout; const char* wuv;
    __device__ bool next(int i, pg8::Unit& u) const { const int idx = i * G + c - 32; if (idx < 0 || idx >= 32) return false; const int pm = idx >> 3, h = idx & 7;
        u.a = wbout + ((size_t)pm * 256 * 1024 + h * 128) * 2; u.b = wuv + (size_t)h * 256 * 128 * 2; u.row0 = pm * 256; u.col0 = h * 256; u.aux = 0; u.rows = nullptr; u.nrows = 256; return true; }
    __device__ __forceinline__ void ready(const pg8::Unit&) const {}
    __device__ __forceinline__ void ready_first(const pg8::Unit&) const {}
    __device__ __forceinline__ void done(const pg8::Unit&) const {}
};

constexpr int PW_ = 3072;
__device__ __forceinline__ unsigned f2key_d(float f) { f += 0.0f; const unsigned u = __float_as_uint(f); return (u & 0x80000000u) ? ~u : (u | 0x80000000u); }
__device__ __forceinline__ int wave_sum_i(int v) {
    v += __builtin_amdgcn_update_dpp(0, v, 0x111, 0xf, 0xf, false);
    v += __builtin_amdgcn_update_dpp(0, v, 0x112, 0xf, 0xf, false);
    v += __builtin_amdgcn_update_dpp(0, v, 0x114, 0xf, 0xf, false);
    v += __builtin_amdgcn_update_dpp(0, v, 0x118, 0xf, 0xf, false);
    v += __builtin_amdgcn_update_dpp(0, v, 0x142, 0xa, 0xf, false);
    v += __builtin_amdgcn_update_dpp(0, v, 0x143, 0xc, 0xf, false);
    return __builtin_amdgcn_readlane(v, 63);
}
__device__ __forceinline__ int wave_scan_i(int v) {
    v += __builtin_amdgcn_update_dpp(0, v, 0x111, 0xf, 0xf, false);
    v += __builtin_amdgcn_update_dpp(0, v, 0x112, 0xf, 0xf, false);
    v += __builtin_amdgcn_update_dpp(0, v, 0x114, 0xf, 0xf, false);
    v += __builtin_amdgcn_update_dpp(0, v, 0x118, 0xf, 0xf, false);
    v += __builtin_amdgcn_update_dpp(0, v, 0x142, 0xa, 0xf, false);
    v += __builtin_amdgcn_update_dpp(0, v, 0x143, 0xc, 0xf, false);
    return v;
}
__device__ __forceinline__ unsigned umax_(unsigned a, unsigned b) { return a > b ? a : b; }
__device__ __forceinline__ unsigned umin_(unsigned a, unsigned b) { return a < b ? a : b; }
__device__ __forceinline__ unsigned wave_max_u(unsigned v) {
    v = umax_(v, (unsigned)__builtin_amdgcn_update_dpp(0, (int)v, 0x111, 0xf, 0xf, false)); v = umax_(v, (unsigned)__builtin_amdgcn_update_dpp(0, (int)v, 0x112, 0xf, 0xf, false));
    v = umax_(v, (unsigned)__builtin_amdgcn_update_dpp(0, (int)v, 0x114, 0xf, 0xf, false)); v = umax_(v, (unsigned)__builtin_amdgcn_update_dpp(0, (int)v, 0x118, 0xf, 0xf, false));
    v = umax_(v, (unsigned)__builtin_amdgcn_update_dpp(0, (int)v, 0x142, 0xa, 0xf, false)); v = umax_(v, (unsigned)__builtin_amdgcn_update_dpp(0, (int)v, 0x143, 0xc, 0xf, false));
    return (unsigned)__builtin_amdgcn_readlane((int)v, 63);
}
__device__ __forceinline__ unsigned wave_min_u(unsigned v) {
    v = umin_(v, (unsigned)__builtin_amdgcn_update_dpp(-1, (int)v, 0x111, 0xf, 0xf, false)); v = umin_(v, (unsigned)__builtin_amdgcn_update_dpp(-1, (int)v, 0x112, 0xf, 0xf, false));
    v = umin_(v, (unsigned)__builtin_amdgcn_update_dpp(-1, (int)v, 0x114, 0xf, 0xf, false)); v = umin_(v, (unsigned)__builtin_amdgcn_update_dpp(-1, (int)v, 0x118, 0xf, 0xf, false));
    v = umin_(v, (unsigned)__builtin_amdgcn_update_dpp(-1, (int)v, 0x142, 0xa, 0xf, false)); v = umin_(v, (unsigned)__builtin_amdgcn_update_dpp(-1, (int)v, 0x143, 0xc, 0xf, false));
    return (unsigned)__builtin_amdgcn_readlane((int)v, 63);
}
#define CNT4(c0, c1, c2, c3, k0, k1, k2, k3, thr) do { unsigned long long m0_, m1_, m2_, m3_; \
    asm volatile("v_cmp_ge_u32 %4, %8, %12\n\tv_cmp_ge_u32 %5, %9, %12\n\tv_cmp_ge_u32 %6, %10, %12\n\tv_cmp_ge_u32 %7, %11, %12\n\t" \
                 "v_addc_co_u32 %0, %4, 0, %0, %4\n\tv_addc_co_u32 %1, %5, 0, %1, %5\n\tv_addc_co_u32 %2, %6, 0, %2, %6\n\tv_addc_co_u32 %3, %7, 0, %3, %7" \
                 : "+v"(c0), "+v"(c1), "+v"(c2), "+v"(c3), "=&s"(m0_), "=&s"(m1_), "=&s"(m2_), "=&s"(m3_) : "v"(k0), "v"(k1), "v"(k2), "v"(k3), "v"(thr)); } while (0)
template <int NR> __device__ __forceinline__ int count_ge(const unsigned (&k)[NR], unsigned thr) {
    int c0 = 0, c1 = 0, c2 = 0, c3 = 0;
#pragma unroll
    for (int r = 0; r < NR; r += 4) CNT4(c0, c1, c2, c3, k[r], k[r + 1], k[r + 2], k[r + 3], thr);
    return wave_sum_i((c0 + c1) + (c2 + c3));
}
constexpr int CAPL = 12;
__device__ __forceinline__ int count_geC(const unsigned (&c)[CAPL], unsigned thr) {
    int c0 = 0, c1 = 0, c2 = 0, c3 = 0;
#pragma unroll
    for (int r = 0; r < CAPL; r += 4) CNT4(c0, c1, c2, c3, c[r], c[r + 1], c[r + 2], c[r + 3], thr);
    return wave_sum_i((c0 + c1) + (c2 + c3));
}
template <int NR> __device__ __forceinline__ void select_query(LAS unsigned* KEYS, LAS unsigned* HIST, LAS unsigned short* SEL, unsigned short* idx_out, int lane, int w, int tq, int nk32) {
              unsigned k[NR];
#pragma unroll
              for (int r = 0; r < NR; ++r) { const int idx = 64 * r + lane; k[r] = (idx < nk32) ? KEYS[w * 4096 + idx] : 0u; }
              unsigned kmax = 0u, kmin = 0xffffffffu;
#pragma unroll
              for (int r = 0; r < NR; ++r) { kmax = k[r] > kmax ? k[r] : kmax; const unsigned v = k[r] ? k[r] : 0xffffffffu; kmin = v < kmin ? v : kmin; }
              kmax = wave_max_u(kmax); kmin = wave_min_u(kmin);
              unsigned lo = kmin, hi = kmax + 1u; int clo = tq + 1, chi = 0; bool exact = false;
              int iter = 0;
              for (;; ++iter) { const unsigned span = hi - lo; if (span <= 1u || clo - chi <= 256) break;
                  unsigned off = span >> 1;
                  if (!(iter & 1)) { const float fr = (float)(clo - 256) * __builtin_amdgcn_rcpf((float)(clo - chi)); off = (unsigned)((float)span * fr); off = off < 1u ? 1u : (off > span - 1u ? span - 1u : off); }
                  const unsigned mid = lo + off;
                  const int c = count_ge<NR>(k, mid);
                  if (c == 256) { lo = mid; exact = true; break; }
                  if (c > 256) { lo = mid; clo = c; } else { hi = mid; chi = c; } }
              if (!exact && hi - lo > 1u) {
                  unsigned slot = lane;
#pragma unroll
                  for (int r = 0; r < NR; ++r) { const bool in = (k[r] - lo) < (hi - lo); const unsigned sl = (in && slot < 64u * CAPL) ? slot : (64u * CAPL + lane); HIST[sl] = k[r]; slot += in ? 64u : 0u; }
                  const int cntl = (int)((slot - lane) >> 6);
                  const bool full = __builtin_amdgcn_ballot_w64(cntl > CAPL) != 0ull;
                  LDS_WAIT();
                  unsigned c8[CAPL];
#pragma unroll
                  for (int r = 0; r < CAPL; ++r) c8[r] = (r < cntl) ? HIST[lane + 64 * r] : 0u;
                  const int chi0 = chi;
                  for (;; ++iter) { const unsigned span = hi - lo; if (span <= 1u) break;
                      unsigned off = span >> 1;
                      if (!(iter & 1)) { const float fr = (float)(clo - 256) * __builtin_amdgcn_rcpf((float)(clo - chi)); off = (unsigned)((float)span * fr); off = off < 1u ? 1u : (off > span - 1u ? span - 1u : off); }
                      const unsigned mid = lo + off;
                      const int c = full ? count_ge<NR>(k, mid) : chi0 + count_geC(c8, mid);
                      if (c == 256) { lo = mid; exact = true; break; }
                      if (c > 256) { lo = mid; clo = c; } else { hi = mid; chi = c; } }
              }
              const unsigned thr = exact ? lo : hi; const int need = exact ? 0 : 256 - chi;
              { int cl = 0; { int e0 = 0, e1 = 0, e2 = 0, e3 = 0;
#pragma unroll
                for (int r = 0; r < NR; r += 4) CNT4(e0, e1, e2, e3, k[r], k[r + 1], k[r + 2], k[r + 3], thr);
                cl = (e0 + e1) + (e2 + e3); }
                const int inc = wave_scan_i(cl);
                int off = inc - cl;
#pragma unroll
                for (int r = 0; r < NR; ++r) { const bool pr = k[r] >= thr; SEL[pr ? off : 256 + lane] = (unsigned short)(64 * r + lane); off += pr ? 1 : 0; } }
              if (need > 0) { const unsigned long long ltmask = (1ull << lane) - 1ull; const int base = 256 - need; int tb = 0;
#pragma unroll
                  for (int r = 0; r < NR; ++r) { const bool pr = k[r] == lo; const unsigned long long m = __builtin_amdgcn_ballot_w64(pr); const int rk = tb + __popcll(m & ltmask);
                      if (pr && rk < need) SEL[base + rk] = (unsigned short)(64 * r + lane); tb += __popcll(m); } }
              LDS_WAIT();
              *(v2u*)(idx_out + 4 * lane) = *(const LAS v2u*)(SEL + 4 * lane);
}

__device__ __forceinline__ void p10_index(Frame& F, const Args& args, const XcdBarrier& bar, bool do_norm) {
    unsigned char* ws = F.ws; bf16* PROJ = (bf16*)(ws + WS_D); unsigned short* IDX = (unsigned short*)(ws + WS_G); const float* kvg = args.in[10];
    unsigned char* KF = ws + WS_KF;
    const int lane = ((int)threadIdx.x & 63), w = F.wave;
    if (do_norm) {
        for (int row0 = F.vcu * NWAVES + w; row0 < T; row0 += 8 * F.G * NWAVES) {
            v2u a[8];
#pragma unroll
            for (int u = 0; u < 8; ++u) { const int row = row0 + u * F.G * NWAVES; a[u] = *(const v2u*)(PROJ + (size_t)(row < T ? row : row0) * PW_ + 2048 + 4 * lane); }
            const f32x4 g = *(const f32x4*)(kvg + 4 * lane);
#pragma unroll
            for (int u = 0; u < 8; ++u) { const int row = row0 + u * F.G * NWAVES;
                const float x0 = bflo(a[u].x), x1 = bfhi(a[u].x), x2 = bflo(a[u].y), x3 = bfhi(a[u].y); const float ss = wave_sum_fast((x0 * x0 + x1 * x1) + (x2 * x2 + x3 * x3));
                const float rs = rsqrtf(ss * (1.f / 256.f) + 1e-6f);
                v2u o; o.x = pk2(x0 * rs * g[0], x1 * rs * g[1]); o.y = pk2(x2 * rs * g[2], x3 * rs * g[3]);
                if (row < T) *(v2u*)(PROJ + (size_t)row * PW_ + 2048 + 4 * lane) = o; } }
    }
    LAS unsigned* KEYS = (LAS unsigned*)F.lds;
    LAS unsigned* HIST = (LAS unsigned*)(F.lds + XTRA_OFF + w * 3328);
    LAS unsigned short* SEL = (LAS unsigned short*)(F.lds + XTRA_OFF + 26624) + w * 320;
    const int r32 = lane & 31, hh = lane >> 5;
    const int qa = (r32 >> 4) & 1, qb = (r32 >> 3) & 1, qc = (r32 >> 2) & 1, qd = r32 & 3;
    for (int gq = 0;; ++gq) {
        const int pr_ = __builtin_amdgcn_readfirstlane(F.vcu + F.G * (gq >> 1)); if (pr_ >= T / 16) break;
        const int b = pr_ >> 8, cc_ = pr_ & 255; const int t0 = ((gq & 1) ? 511 - cc_ : cc_) * 8;
        if (t0 + 8 <= 256) continue;
        const int nk = t0 + 8, ntile = (nk + 31) >> 5, nk32 = ntile * 32;
        const size_t brow = (size_t)b * SEQ;
        for (int rs_ = 0; rs_ < 1 + P10_DUP_SCORE; ++rs_) {
          const unsigned char* kfb = KF + (size_t)b * 128 * 4096 + (hh * 32 + r32) * 16;
#define P10_LOADB(dst, kt0_) do { _Pragma("unroll") for (int u = 0; u < 2; ++u) { const int kt_ = (kt0_) + 8 * u; const unsigned char* kp_ = kfb + (size_t)(kt_ < ntile ? kt_ : 0) * 4096; \
              _Pragma("unroll") for (int ks = 0; ks < 4; ++ks) dst[u][ks] = *(const bf16x8*)(kp_ + ks * 1024); } } while (0)
#define P10_COMP(src, kt0_) do { _Pragma("unroll") for (int u = 0; u < 2; ++u) { const int kt = (kt0_) + 8 * u; \
              if (kt < ntile) { const int key = kt * 32 + r32; \
                  _Pragma("unroll") for (int mi = 0; mi < 2; ++mi) { f32x16 acc; \
                      _Pragma("unroll") for (int i = 0; i < 16; ++i) acc[i] = 0.f; \
                      _Pragma("unroll") for (int ks = 0; ks < 4; ++ks) acc = __builtin_amdgcn_mfma_f32_32x32x16_bf16(Af[mi][ks], src[u][ks], acc, 0, 0, 0); \
                      _Pragma("unroll") for (int a = 0; a < 2; ++a) { float sc = 0.f; \
                          _Pragma("unroll") for (int bb = 0; bb < 2; ++bb) _Pragma("unroll") for (int d = 0; d < 4; ++d) sc += fmaxf(acc[4 * (2 * a + bb) + d], 0.f) * wq[mi][a][4 * bb + d]; \
                          const int ql = 4 * mi + 2 * hh + a; const int tq = t0 + ql; \
                          KEYS[ql * 4096 + key] = (key <= tq) ? f2key_d(sc) : 0u; } } } } } while (0)
          bf16x8 B0[2][4], B1[2][4];
          P10_LOADB(B0, w);
          bf16x8 Af[2][4]; float wq[2][2][8];
#pragma unroll
          for (int mi = 0; mi < 2; ++mi) { const bf16* qp = PROJ + (brow + t0 + 4 * mi + 2 * qc + qa) * PW_ + 2304 + (4 * qb + qd) * 64 + 8 * hh;
#pragma unroll
              for (int ks = 0; ks < 4; ++ks) Af[mi][ks] = *(const bf16x8*)(qp + 16 * ks);
#pragma unroll
              for (int a = 0; a < 2; ++a) { const v4u wv = *(const v4u*)(PROJ + (brow + t0 + 4 * mi + 2 * hh + a) * PW_ + 2880);
                  wq[mi][a][0] = bflo(wv.x); wq[mi][a][1] = bfhi(wv.x); wq[mi][a][2] = bflo(wv.y); wq[mi][a][3] = bfhi(wv.y); wq[mi][a][4] = bflo(wv.z); wq[mi][a][5] = bfhi(wv.z); wq[mi][a][6] = bflo(wv.w); wq[mi][a][7] = bfhi(wv.w);
#pragma unroll
                  for (int h = 0; h < 8; ++h) wq[mi][a][h] *= 0.04419417382415922f; } }
          {
            for (int kt0 = w; kt0 < ntile; kt0 += 32) {
                if (kt0 + 16 < ntile) P10_LOADB(B1, kt0 + 16);
                P10_COMP(B0, kt0);
                if (kt0 + 16 < ntile) { if (kt0 + 32 < ntile) P10_LOADB(B0, kt0 + 32); P10_COMP(B1, kt0 + 16); }
            } }
#undef P10_LOADB
#undef P10_COMP
          }
        __syncthreads();
        { const int tq = t0 + w;
          if (tq >= 256) { unsigned short* io = IDX + (brow + tq) * 256;
              if (nk32 <= 512) select_query<8>(KEYS, HIST, SEL, io, lane, w, tq, nk32);
              else if (nk32 <= 1024) select_query<16>(KEYS, HIST, SEL, io, lane, w, tq, nk32);
              else if (nk32 <= 1536) select_query<24>(KEYS, HIST, SEL, io, lane, w, tq, nk32);
              else if (nk32 <= 2048) select_query<32>(KEYS, HIST, SEL, io, lane, w, tq, nk32);
              else if (nk32 <= 2560) select_query<40>(KEYS, HIST, SEL, io, lane, w, tq, nk32);
              else if (nk32 <= 3072) select_query<48>(KEYS, HIST, SEL, io, lane, w, tq, nk32);
              else if (nk32 <= 3584) select_query<56>(KEYS, HIST, SEL, io, lane, w, tq, nk32);
              else select_query<64>(KEYS, HIST, SEL, io, lane, w, tq, nk32);
#if P10_DUP_SEL
              asm volatile("" ::: "memory");
              if (nk32 <= 512) select_query<8>(KEYS, HIST, SEL, io, lane, w, tq, nk32);
              else if (nk32 <= 1024) select_query<16>(KEYS, HIST, SEL, io, lane, w, tq, nk32);
              else if (nk32 <= 1536) select_query<24>(KEYS, HIST, SEL, io, lane, w, tq, nk32);
              else if (nk32 <= 2048) select_query<32>(KEYS, HIST, SEL, io, lane, w, tq, nk32);
              else if (nk32 <= 2560) select_query<40>(KEYS, HIST, SEL, io, lane, w, tq, nk32);
              else if (nk32 <= 3072) select_query<48>(KEYS, HIST, SEL, io, lane, w, tq, nk32);
              else if (nk32 <= 3584) select_query<56>(KEYS, HIST, SEL, io, lane, w, tq, nk32);
              else select_query<64>(KEYS, HIST, SEL, io, lane, w, tq, nk32);
#endif
          } }
        __syncthreads();
    }
}

__device__ __forceinline__ void p11_attn(Frame& F) {
    unsigned char* ws = F.ws; const bf16* PROJ = (const bf16*)(ws + WS_D); const unsigned short* IDX = (const unsigned short*)(ws + WS_G); bf16* OLAT = (bf16*)(ws + WS_B);
    const int lane = ((int)threadIdx.x & 63), w = F.wave, lr = lane & 15, g = lane >> 4, hf = lane >> 5, c32 = lane & 31;
    LAS unsigned char* IMG = F.lds + w * 16384;
    LAS unsigned short* KLB = (LAS unsigned short*)(F.lds + XTRA_OFF) + w * 512;
    const unsigned rho0 = 8 * (lr >> 2) + (lr & 3);
    const unsigned wimg = (c32 >> 4) * 8192;
#if P11_STAGGER
    for (int d_ = 0; d_ < P11_STAGGER * w; ++d_) __builtin_amdgcn_s_sleep(8);
#endif
#define P11_KEYS(dst, q_) do { const int t_ = (q_) & 4095; const int cnt_ = t_ + 1 < 256 ? t_ + 1 : 256; const int p0_ = 4 * lane; \
        if (t_ >= 256) dst = *(const v2u*)(IDX + (size_t)(q_) * 256 + p0_); \
        else { const unsigned a0 = p0_ < cnt_ ? p0_ : 0, a1 = p0_ + 1 < cnt_ ? p0_ + 1 : 0, a2 = p0_ + 2 < cnt_ ? p0_ + 2 : 0, a3 = p0_ + 3 < cnt_ ? p0_ + 3 : 0; dst.x = a0 | (a1 << 16); dst.y = a2 | (a3 << 16); } } while (0)
    const int q0 = F.vcu * NWAVES + w, qstep = F.G * NWAVES;
    if (q0 < T) { v2u kk; P11_KEYS(kk, q0); *(LAS v2u*)(KLB + 4 * lane) = kk; }
    int par = 0;
    for (int q = q0; q < T; q += qstep, par ^= 1) {
        const int b = q >> 12, t = q & 4095; const size_t brow = (size_t)b * SEQ; const size_t row = (size_t)q;
        const int cnt = t + 1 < 256 ? t + 1 : 256;
        LAS unsigned short* KL = KLB + par * 256;
        v2u kkn = {0u, 0u}; const bool hasn = q + qstep < T;
        if (hasn) P11_KEYS(kkn, q + qstep);
        bf16x8 Qf[8];
#pragma unroll
        for (int ks = 0; ks < 8; ++ks) { bf16x8 v = *(const bf16x8*)(PROJ + row * PW_ + (lr & 7) * 256 + 32 * ks + 8 * g); if (lr >= 8) v = (bf16x8){0, 0, 0, 0, 0, 0, 0, 0}; Qf[ks] = v; }
        f32x4 O[16];
#pragma unroll
        for (int n = 0; n < 16; ++n) O[n] = (f32x4){0.f, 0.f, 0.f, 0.f};
        float m_run = -INFINITY, l_run = 0.f;
        const char* ckb = (const char*)(PROJ + brow * PW_ + 2048); const unsigned coff = 16u * c32;
        bf16x8 Cr[16];
        LDS_WAIT();
#define P11_LOAD(ch_) do { const v4u k0_ = *(const LAS v4u*)(KL + (ch_) * 32 + 16 * hf), k1_ = *(const LAS v4u*)(KL + (ch_) * 32 + 16 * hf + 8); \
            const unsigned kq_[8] = {k0_.x, k0_.y, k0_.z, k0_.w, k1_.x, k1_.y, k1_.z, k1_.w}; \
            _Pragma("unroll") for (int j_ = 0; j_ < 16; ++j_) { const unsigned key_ = (j_ & 1) ? (kq_[j_ >> 1] >> 16) : (kq_[j_ >> 1] & 0xffffu); \
                Cr[j_] = *(const bf16x8*)(ckb + (key_ * (unsigned)(PW_ * 2) + coff)); } } while (0)
        P11_LOAD(0);
#pragma unroll
        for (int ch = 0; ch < 8; ++ch) {
            const int kbase = ch * 32;
            if (kbase < cnt) {
                for (int rw_ = 0; rw_ < 1 + P11_DUP_WR; ++rw_) {
#pragma unroll
                for (int j = 0; j < 16; ++j) *(LAS bf16x8*)(IMG + wimg + off_b(8 * (j >> 2) + (j & 3) + 4 * hf, c32 & 15)) = Cr[j];
                LDS_WAIT(); }
                if (ch < 7) { if (kbase + 32 < cnt) { for (int rl2_ = 0; rl2_ < 1 + P11_DUP_LD; ++rl2_) { P11_LOAD(ch + 1); asm volatile("" ::: "memory"); } } }
                f32x4 S[2];
                for (int rq_ = 0; rq_ < 1 + P11_DUP_QK; ++rq_)
#pragma unroll
                for (int rb = 0; rb < 2; ++rb) { S[rb] = (f32x4){0.f, 0.f, 0.f, 0.f};
#pragma unroll
                    for (int ks = 0; ks < 8; ++ks) { const unsigned cidx = 4 * ks + g; const bf16x8 Af = *(const LAS bf16x8*)(IMG + (cidx >> 4) * 8192 + off_b(rho0 + 4 * rb, cidx & 15));
                        S[rb] = __builtin_amdgcn_mfma_f32_16x16x32_bf16(Af, Qf[ks], S[rb], 0, 0, 0); } }
                float cm = -INFINITY;
#pragma unroll
                for (int rb = 0; rb < 2; ++rb)
#pragma unroll
                    for (int i = 0; i < 4; ++i) { const int kk = kbase + 16 * rb + 4 * g + i; if (kk >= cnt) S[rb][i] = -INFINITY; cm = fmaxf(cm, S[rb][i]); }
                cm = xg_max(cm);
                const float m_new = fmaxf(m_run, cm); const float alpha = __builtin_amdgcn_exp2f((m_run - m_new) * 1.4426950408889634f); float rs = 0.f; float p[2][4];
#pragma unroll
                for (int rb = 0; rb < 2; ++rb)
#pragma unroll
                    for (int i = 0; i < 4; ++i) { p[rb][i] = __builtin_amdgcn_exp2f((S[rb][i] - m_new) * 1.4426950408889634f); rs += p[rb][i]; }
                rs = xg_sum(rs);
                l_run = l_run * alpha + rs; m_run = m_new;
                if (__builtin_amdgcn_ballot_w64(alpha != 1.0f) != 0ull) {
#pragma unroll
                    for (int n = 0; n < 16; ++n) O[n] = O[n] * alpha;
                }
                bf16x8 Pf; { const unsigned a0 = pk2(p[0][0], p[0][1]), a1 = pk2(p[0][2], p[0][3]), a2 = pk2(p[1][0], p[1][1]), a3 = pk2(p[1][2], p[1][3]);
                    Pf = (bf16x8){(short)(a0 & 0xffff), (short)(a0 >> 16), (short)(a1 & 0xffff), (short)(a1 >> 16), (short)(a2 & 0xffff), (short)(a2 >> 16), (short)(a3 & 0xffff), (short)(a3 >> 16)}; }
                bf16x8 Ba[2], Bb[2];
#define P11_TR(dst, n0) do { _Pragma("unroll") for (int j_ = 0; j_ < 2; ++j_) { const int n_ = (n0) + j_; LAS unsigned char* ib_ = IMG + (n_ >> 3) * 8192; \
                    const bf16x4 lo_ = tr_read(ib_ + tr_read_addr_16(lane, n_ & 7, 0, 0)), hi_ = tr_read(ib_ + tr_read_addr_16(lane, n_ & 7, 0, 1)); \
                    dst[j_] = (bf16x8){lo_[0], lo_[1], lo_[2], lo_[3], hi_[0], hi_[1], hi_[2], hi_[3]}; } } while (0)
#define P11_MM(src, n0) do { _Pragma("unroll") for (int j_ = 0; j_ < 2; ++j_) O[(n0) + j_] = __builtin_amdgcn_mfma_f32_16x16x32_bf16(src[j_], Pf, O[(n0) + j_], 0, 0, 0); } while (0)
                P11_TR(Ba, 0); P11_TR(Bb, 2); P11_MM(Ba, 0); P11_TR(Ba, 4); P11_MM(Bb, 2); P11_TR(Bb, 6); P11_MM(Ba, 4); P11_TR(Ba, 8); P11_MM(Bb, 6); P11_TR(Bb, 10); P11_MM(Ba, 8); P11_TR(Ba, 12); P11_MM(Bb, 10); P11_TR(Bb, 14); P11_MM(Ba, 12); P11_MM(Bb, 14);
#undef P11_TR
#undef P11_MM
                LDS_WAIT();
                if (ch == 0) { if (hasn) *(LAS v2u*)(KLB + (par ^ 1) * 256 + 4 * lane) = kkn; }
            }
        }
#undef P11_LOAD
        const float linv = 1.f / l_run;
        if (lr < 8) {
#pragma unroll
            for (int n = 0; n < 16; ++n) { v2u o; o.x = pk2(O[n][0] * linv, O[n][1] * linv); o.y = pk2(O[n][2] * linv, O[n][3] * linv);
                *(v2u*)(OLAT + row * 2048 + lr * 256 + 16 * n + 4 * g) = o; }
        }
    }
}
#undef P11_KEYS

__device__ __forceinline__ void tail_phases(Frame& F, const Args& args, const XcdBarrier& bar, int lo, int hi, int base, int L, const bf16* R, float* outf, bf16* outb) {
    unsigned char* ws = F.ws;
#define INB(k) (lo <= base + (k) && base + (k) < hi)
#define REPSB(k) (INB(k) ? 1 + ((DUP_MASK >> (base + (k))) & 1) : 0)
#define SEAMB(k) do { if (INB(k) && INB((k) + 1)) { xcd_barrier(bar); if (BAR_DUP) xcd_barrier(bar); } } while (0)
    for (int rep_ = 0; rep_ < REPSB(0); ++rep_) { p4_ln_router(F, args, L, R, (bf16*)(ws + WS_A)); }
    SEAMB(0);
    for (int rep_ = 0; rep_ < REPSB(1); ++rep_) {
        moe_tab_build(F, L);
        pg8::Gemm g{1024, 1024, 1024}; MoeSched1 S{moe_tab(F), F.G, F.vcu, (const char*)(ws + WS_A), (const char*)(ws + WS_WE_IN) + (size_t)L * 32 * 512 * 1024 * 2, (const int*)(ws + WS_LIST)};
        EpiMoe1 E{(bf16*)(ws + WS_D), (const float*)(ws + WS_GLIST)};
        pg8::gemm_phase<EpiMoe1, MoeSched1, true>(F.lds, g, S, E);
        { pg8::Gemm g2{256, 256, 256}; PwSched S2{(LAS int*)(F.lds + XTRA_OFF), F.G, F.vcu, (const char*)(ws + WS_PB) + (size_t)L * T * 256 * 2, (const char*)(ws + WS_WP) + (size_t)L * 1024 * 256 * 2};
          pg8::EpiBf16<0> E2{(bf16*)(ws + WS_B), 1024, nullptr, 1.f};
          pg8::gemm_phase<pg8::EpiBf16<0>, PwSched, false>(F.lds, g2, S2, E2); }
        if (L == 0 && rep_ == 0) {
            const int nt_ = moe_tab(F).nt[0]; int nheavy = 2 * nt_ - F.G; nheavy = nheavy < 0 ? 0 : (nheavy > F.G / 2 ? F.G / 2 : nheavy);
            __syncthreads();
            if (F.vcu >= nheavy) cvt_late(F, args, (F.vcu - nheavy) * NWAVES + F.wave, (F.G - nheavy) * NWAVES);
        }
    }
    SEAMB(1);
    for (int rep_ = 0; rep_ < REPSB(2); ++rep_) {
        moe_tab_build(F, L);
        pg8::Gemm g{256, 256, 256}; MoeSched2 S{moe_tab(F), F.G, F.vcu, (const char*)(ws + WS_D), (const char*)(ws + WS_WE_OUT) + (size_t)L * 32 * 1024 * 256 * 2};
        pg8::EpiBf16<0> E{(bf16*)(ws + WS_E), 1024, nullptr, 1.f};
        pg8::gemm_phase<pg8::EpiBf16<0>, MoeSched2, false>(F.lds, g, S, E);
    }
    SEAMB(2);
    for (int rep_ = 0; rep_ < REPSB(3); ++rep_) { moe_tab_build(F, L); p7_ln2(F, args, L, (const bf16*)(ws + WS_A), (const bf16*)(ws + WS_E), (bf16*)(ws + WS_G)); }
    SEAMB(3);
    for (int rep_ = 0; rep_ < REPSB(4); ++rep_) { p8_ple(F, args, L, (const bf16*)(ws + WS_G), (bf16*)(ws + WS_B), outf, outb); }
#undef INB
#undef REPSB
#undef SEAMB
}
struct EpiProj {
    static constexpr bool PERM = true;
    bf16* O; unsigned char* KF;
    __device__ __forceinline__ void operator()(const f32x4 (&acc)[2][2][4][2], const pg8::Unit& u, int wr, int wc, int fr, int fq) const {
        const int row0 = u.row0 + wr * 64 + fr; const int col0 = u.col0 + wc * 32 + 8 * fq; const bool kt = (u.col0 == 2816) && (wc < 2);
#pragma unroll
        for (int ai = 0; ai < 2; ++ai)
#pragma unroll
            for (int m = 0; m < 4; ++m) { const int row = row0 + ai * 128 + m * 16; bf16* rowp = O + (size_t)row * 3072 + col0;
#pragma unroll
                for (int bj = 0; bj < 2; ++bj) { const f32x4 v0 = acc[ai][bj][m][0] + 0.f, v1 = acc[ai][bj][m][1] + 0.f;
                    v4u w; w.x = pg8::cvt_pk_bf16(v0[0], v0[1]); w.y = pg8::cvt_pk_bf16(v0[2], v0[3]); w.z = pg8::cvt_pk_bf16(v1[0], v1[1]); w.w = pg8::cvt_pk_bf16(v1[2], v1[3]);
                    *(v4u*)(rowp + bj * 128) = w;
                    if (bj == 0 && kt) *(v4u*)(KF + (size_t)(row >> 5) * 4096 + ((4 * wc + fq) * 32 + (row & 31)) * 16) = w; } }
    }
};
__global__ void __launch_bounds__(NWAVES * 64, 2) mega(Args args) {
    extern __shared__ __attribute__((aligned(16))) unsigned char lds_raw[];
    Frame F;
    F.lds = (LAS unsigned char*)lds_raw;
    F.wave = __builtin_amdgcn_readfirstlane((int)threadIdx.x >> 6);
    F.G = gridDim.x; { const int bx = blockIdx.x; F.vcu = (F.G % 8 == 0) ? (bx % 8) * (F.G / 8) + bx / 8 : bx; }
    F.ws = args.ws;
    unsigned char* ws = args.ws;
    const int lo = args.ph_lo, hi = args.ph_hi;
    XcdBarrier bar; bar.bar = (unsigned*)(ws + WS_CTL) + CW_BAR + args.li * XCD_BAR_WORDS; bar.x = 0; bar.st = (volatile LAS unsigned*)(F.lds + BAR_LDS_OFF);
    {
        if (threadIdx.x == 0) { bar.st[0] = 0u; bar.st[1] = 0u; }
        __syncthreads();
        bar = xcd_barrier_post((unsigned*)(ws + WS_CTL) + CW_BAR + args.li * XCD_BAR_WORDS, (volatile LAS unsigned*)(F.lds + BAR_LDS_OFF));
    }
#define IN(k) (lo <= (k) && (k) < hi)
#define REPS(k) (IN(k) ? 1 + ((DUP_MASK >> (k)) & 1) : 0)
#define SEAM(k) do { if (IN(k) && IN((k) + 1)) { xcd_barrier(bar); if (BAR_DUP) xcd_barrier(bar); } } while (0)
    for (int rep_ = 0; rep_ < REPS(0); ++rep_) { p0_convert(F, args); }
    SEAM(0);
    for (int rep_ = 0; rep_ < REPS(1); ++rep_) {
        { pg8::Gemm g{128, 128, 1024}; WqlatSched S{F.G, F.vcu, (const char*)(ws + WS_WUK), (const char*)(ws + WS_WBQ)}; pg8::EpiBf16<0> E{(bf16*)(ws + WS_WB_IN), 1024, nullptr, 0.08838834764831845f};
          pg8::gemm_phase<pg8::EpiBf16<0>, WqlatSched, false>(F.lds, g, S, E); }
        { pg8::Gemm g{128, 1024, 128}; WcombSched S{F.G, F.vcu, (const char*)(ws + WS_WBOUT), (const char*)(ws + WS_WUV)}; pg8::EpiBf16<0> E{(bf16*)(ws + WS_WB_COMB), 2048, nullptr, 1.f};
          pg8::gemm_phase<pg8::EpiBf16<0>, WcombSched, false>(F.lds, g, S, E); }
        pg8::Gemm g{1024, 1024, 1024}; pg8::StaticOrder S; S.init(T, 2048, F.G, (int)blockIdx.x, ws + WS_A, ws + WS_WA_IN, 1024, 1024);
        pg8::EpiBf16<1> E{(bf16*)(ws + WS_B), 2048, args.in[3], 1.f};
        pg8::gemm_phase<pg8::EpiBf16<1>, pg8::StaticOrder, false>(F.lds, g, S, E);
    }
    SEAM(1);
    for (int rep_ = 0; rep_ < REPS(2); ++rep_) { p2_spatial(F, args); }
    SEAM(2);
    for (int rep_ = 0; rep_ < REPS(3); ++rep_) {
        pg8::Gemm g{1024, 1024, 1024}; pg8::StaticOrder S; S.init(T, 1024, F.G, (int)blockIdx.x, ws + WS_A, ws + WS_WA_OUT, 1024, 1024);
        pg8::EpiRes<true> E{args.in[0], (bf16*)(ws + WS_B), 1024, ALPHA};
        pg8::gemm_phase<pg8::EpiRes<true>, pg8::StaticOrder, false>(F.lds, g, S, E);
    }
    SEAM(3);
    tail_phases(F, args, bar, lo, hi, 4, 0, (const bf16*)(ws + WS_B), nullptr, (bf16*)(ws + WS_C));
    SEAM(8);
    for (int rep_ = 0; rep_ < REPS(9); ++rep_) {
        pg8::Gemm g{1024, 1024, 1024}; pg8::StaticOrder S; S.init(T, 3072, F.G, (int)blockIdx.x, ws + WS_C, ws + WS_WB_IN, 1024, 1024);
        EpiProj E{(bf16*)(ws + WS_D), ws + WS_KF};
        pg8::gemm_phase<EpiProj, pg8::StaticOrder, false>(F.lds, g, S, E);
    }
    SEAM(9);
    for (int rep_ = 0; rep_ < REPS(10); ++rep_) { p10_index(F, args, bar, rep_ == 0 && args.pad == 0); }
    SEAM(10);
    for (int rep_ = 0; rep_ < REPS(11); ++rep_) { p11_attn(F); }
    SEAM(11);
    for (int rep_ = 0; rep_ < REPS(12); ++rep_) {
        pg8::Gemm g{2048, 2048, 2048}; pg8::StaticOrder S; S.init(T, 1024, F.G, (int)blockIdx.x, ws + WS_B, ws + WS_WB_COMB, 2048, 2048);
        pg8::EpiRes<false> E{(const bf16*)(ws + WS_C), (bf16*)(ws + WS_F), 1024, ALPHA};
        pg8::gemm_phase<pg8::EpiRes<false>, pg8::StaticOrder, false>(F.lds, g, S, E);
    }
    SEAM(12);
    tail_phases(F, args, bar, lo, hi, 13, 1, (const bf16*)(ws + WS_F), args.out, nullptr);
#undef IN
#undef SEAM
}


extern "C" void kernel_launch(void* const* d_in, const int* in_sizes, int n_in, void* d_out, int out_size, void* d_ws, size_t ws_size, hipStream_t stream) {
    const size_t UNIT = (size_t)T * 1024 * 4;
    static int grid = 0;
    if (grid == 0) {
        if (n_in != 27 || ws_size < 8 * UNIT || out_size != T * D) { fprintf(stderr, "kernel_launch: unexpected shapes n_in %d ws %zu out %d\n", n_in, ws_size, out_size); grid = -1; return; }
        int dev = 0, cus = 0;
        if (hipGetDevice(&dev) != hipSuccess || hipDeviceGetAttribute(&cus, hipDeviceAttributeMultiprocessorCount, dev) != hipSuccess) { grid = -1; return; }
        if (hipFuncSetAttribute((const void*)mega, hipFuncAttributeMaxDynamicSharedMemorySize, LDS_BYTES) != hipSuccess) { fprintf(stderr, "hipFuncSetAttribute failed\n"); grid = -1; return; }
        grid = cus;
    }
    if (grid < 0) return;
    char* ws = (char*)d_ws;

    hipMemsetAsync(ws + WS_CTL, 0, CTL_ZERO_BYTES, stream);
    Args a{};
    for (int i = 0; i < 27; ++i) a.in[i] = (const float*)d_in[i];
    a.out = (float*)d_out; a.ws = (unsigned char*)d_ws;
    int nlaunch = 0;
    auto phase = [&](int lo, int hi) { a.ph_lo = lo; a.ph_hi = hi; a.li = (nlaunch++) % 3; hipLaunchKernelGGL(mega, dim3(grid), dim3(NWAVES * 64), LDS_BYTES, stream, a); };
    constexpr int NPHASE = 18;
#if defined(DUP_PHASE)
    phase(0, DUP_PHASE + 1); a.pad = 1; phase(DUP_PHASE, DUP_PHASE + 1); a.pad = 0; if (DUP_PHASE + 1 < NPHASE) phase(DUP_PHASE + 1, NPHASE);
#elif defined(MK_PER_PHASE)
    for (int ph = 0; ph < NPHASE; ++ph) phase(ph, ph + 1);
#else
    phase(0, NPHASE);
#endif
}
```

```cpp
#include <hip/hip_runtime.h>
#include <cstdio>
#include <cstdint>

constexpr int D = 1024, BATCH = 4, SEQ = 4096, T = BATCH * SEQ;
constexpr int CHUNK = 128, GM_G = 8;
constexpr int KVL = 256, IDXH = 8, IDXD = 64, TOPK = 256, NH = 8, HD_ = 128;
constexpr int PROJ_B = 1864;
constexpr int NEXP = 32, EFF = 256, PLE = 256;
constexpr float ALPHA = 1.41421356237309515f;


#define GAS __attribute__((address_space(1)))
#define LAS __attribute__((address_space(3)))
typedef unsigned short bf16;
typedef unsigned v4u __attribute__((ext_vector_type(4)));
typedef unsigned v2u __attribute__((ext_vector_type(2)));
typedef float f32x4 __attribute__((ext_vector_type(4)));
typedef float f32x2 __attribute__((ext_vector_type(2)));
typedef float f32x16 __attribute__((ext_vector_type(16)));
typedef short bf16x8 __attribute__((ext_vector_type(8)));
typedef short bf16x4 __attribute__((ext_vector_type(4)));
#define LDS_WAIT() asm volatile("s_waitcnt lgkmcnt(0)" ::: "memory")
#define VM_WAIT() asm volatile("s_waitcnt vmcnt(0)" ::: "memory")
__device__ __forceinline__ unsigned f2bf(float f) { unsigned u = __builtin_bit_cast(unsigned, f); return (u + 0x7fffu + ((u >> 16) & 1u)) >> 16; }
__device__ __forceinline__ unsigned pk2(float lo, float hi) { unsigned r; asm("v_cvt_pk_bf16_f32 %0, %1, %2" : "=v"(r) : "v"(lo), "v"(hi)); return r; }
__device__ __forceinline__ float bf2f(unsigned short h) { return __builtin_bit_cast(float, (unsigned)h << 16); }
__device__ __forceinline__ float bflo(unsigned w) { return __builtin_bit_cast(float, w << 16); }
__device__ __forceinline__ float bfhi(unsigned w) { return __builtin_bit_cast(float, w & 0xffff0000u); }

namespace pg8 {
constexpr int BM = 256, BK = 64, HALF = 128, HTB = HALF * BK * 2  , STAGE_BYTES = 8 * HTB, NXCD = 8, WGM = 4;
__host__ __device__ __forceinline__ int lds_byte(int r, int c) { const int st = (r >> 4) * 2 + (c >> 5), rr = r & 15, cc = c & 31, ob = rr * 64 + cc * 2; return st * 1024 + (ob ^ (((ob >> 9) & 1) << 5)); }
__host__ __device__ __forceinline__ void stage_rc(int b, int& R, int& C) { const int st = b / 1024, sb = b % 1024, swz = sb ^ (((sb >> 9) & 1) << 5); R = (st >> 1) * 16 + swz / 64; C = (st & 1) * 32 + (swz % 64) / 2; }
__host__ __device__ __forceinline__ int perm32(int rho) { const int n = rho >> 4, i = rho & 15; return 8 * (i >> 2) + 4 * n + (i & 3); }

struct Unit { const char* a; const char* b; int row0, col0, aux; const int* rows; int nrows; };
struct Gemm { int K, lda, ldb; };

struct StaticOrder {
    int nM, nN, nwg, G, c; const char* A; const char* Bt; size_t sa, sb;
    __device__ void init(int M, int N, int G_, int c_, const void* A_, const void* Bt_, int lda, int ldb) { nM = M / BM; nN = N / BM; nwg = nM * nN; G = G_; c = c_; A = (const char*)A_; Bt = (const char*)Bt_; sa = (size_t)BM * lda * 2; sb = (size_t)BM * ldb * 2; }
    __device__ bool next(int i, Unit& u) const {
        const long L = (long)i * G + c; if (L >= nwg) return false;
        int wgid = (int)L; { const int q = nwg / NXCD, r = nwg % NXCD, xcd = wgid % NXCD, off = wgid / NXCD; wgid = (xcd < r ? xcd * (q + 1) : r * (q + 1) + (xcd - r) * q) + off; }
        const int nig = WGM * nN, gid = wgid / nig, fm = gid * WGM, gsz = (nM - fm) < WGM ? (nM - fm) : WGM;
        const int pm = fm + ((wgid % nig) % gsz), pn = (wgid % nig) / gsz;
        u.a = A + (size_t)pm * sa; u.b = Bt + (size_t)pn * sb; u.row0 = pm * BM; u.col0 = pn * BM; u.aux = 0; u.rows = nullptr; u.nrows = 256; return true;
    }
    __device__ __forceinline__ void ready(const Unit&) const {}
    __device__ __forceinline__ void ready_first(const Unit&) const {}
    __device__ __forceinline__ void done(const Unit&) const {}
};

__device__ __forceinline__ unsigned cvt_pk_bf16(float lo, float hi) { unsigned r; asm volatile("v_cvt_pk_bf16_f32 %0, %1, %2" : "=v"(r) : "v"(lo), "v"(hi)); return r; }
__device__ __forceinline__ f32x2 gelu_pk(f32x2 v) {
    const f32x2 av = __builtin_elementwise_abs(v), d = av * 0.2316418882f + 1.0f;
    f32x2 t; t.x = __builtin_amdgcn_rcpf(d.x); t.y = __builtin_amdgcn_rcpf(d.y);
    f32x2 q = t * 0.5307027145f + (-0.7265760135f); q = q * t + 0.7107068705f; q = q * t + (-0.142248368f); q = q * t + 0.127414796f; q = q * t;
    const f32x2 s = (v * v) * (-0.72134752044f);
    f32x2 e; e.x = __builtin_amdgcn_exp2f(s.x); e.y = __builtin_amdgcn_exp2f(s.y);
    const f32x2 m = v * (q * e), r = v - m;
    f32x2 o; o.x = v.x < 0.f ? m.x : r.x; o.y = v.y < 0.f ? m.y : r.y; return o;
}

template <int ACT> struct EpiBf16 {
    static constexpr bool PERM = true;
    bf16* O; int ldc; const float* bias; float scale;
    __device__ __forceinline__ void operator()(const f32x4 (&acc)[2][2][4][2], const Unit& u, int wr, int wc, int fr, int fq) const {
        const int row0 = u.row0 + wr * 64 + fr; const int col0 = u.col0 + wc * 32 + 8 * fq;
        f32x4 bv[2][2];
#pragma unroll
        for (int bj = 0; bj < 2; ++bj)
#pragma unroll
            for (int n = 0; n < 2; ++n) bv[bj][n] = bias ? *(const f32x4*)(bias + col0 + bj * HALF + 4 * n) : (f32x4){0.f, 0.f, 0.f, 0.f};
#pragma unroll
        for (int ai = 0; ai < 2; ++ai)
#pragma unroll
            for (int m = 0; m < 4; ++m) { bf16* rowp = O + (size_t)(row0 + ai * HALF + m * 16) * ldc + col0;
#pragma unroll
                for (int bj = 0; bj < 2; ++bj) { f32x4 v0 = acc[ai][bj][m][0] + bv[bj][0], v1 = acc[ai][bj][m][1] + bv[bj][1];
                    if (ACT == 1) { f32x2 a = gelu_pk((f32x2){v0[0], v0[1]}), b = gelu_pk((f32x2){v0[2], v0[3]}), c = gelu_pk((f32x2){v1[0], v1[1]}), d = gelu_pk((f32x2){v1[2], v1[3]});
                        v0 = (f32x4){a.x, a.y, b.x, b.y}; v1 = (f32x4){c.x, c.y, d.x, d.y}; }
                    v0 = v0 * scale; v1 = v1 * scale; v4u w; w.x = cvt_pk_bf16(v0[0], v0[1]); w.y = cvt_pk_bf16(v0[2], v0[3]); w.z = cvt_pk_bf16(v1[0], v1[1]); w.w = cvt_pk_bf16(v1[2], v1[3]);
                    *(v4u*)(rowp + bj * HALF) = w; } }
    }
};
template <bool XF32> struct EpiRes {
    static constexpr bool PERM = true;
    const void* X; bf16* R; int ldc; float alpha;
    __device__ __forceinline__ void operator()(const f32x4 (&acc)[2][2][4][2], const Unit& u, int wr, int wc, int fr, int fq) const {
        const int col0 = u.col0 + wc * 32 + 8 * fq;
#pragma unroll
        for (int ai = 0; ai < 2; ++ai)
#pragma unroll
            for (int m = 0; m < 4; ++m) { const size_t off = (size_t)(u.row0 + ai * HALF + wr * 64 + m * 16 + fr) * ldc + col0;
#pragma unroll
                for (int bj = 0; bj < 2; ++bj) { f32x4 x0, x1;
                    if (XF32) { x0 = *(const f32x4*)((const float*)X + off + bj * HALF); x1 = *(const f32x4*)((const float*)X + off + bj * HALF + 4); }
                    else { const v4u xb = *(const v4u*)((const bf16*)X + off + bj * HALF); x0 = (f32x4){bflo(xb.x), bfhi(xb.x), bflo(xb.y), bfhi(xb.y)}; x1 = (f32x4){bflo(xb.z), bfhi(xb.z), bflo(xb.w), bfhi(xb.w)}; }
                    const f32x4 r0 = x0 * alpha + acc[ai][bj][m][0], r1 = x1 * alpha + acc[ai][bj][m][1];
                    v4u o; o.x = cvt_pk_bf16(r0[0], r0[1]); o.y = cvt_pk_bf16(r0[2], r0[3]); o.z = cvt_pk_bf16(r1[0], r1[1]); o.w = cvt_pk_bf16(r1[2], r1[3]);
                    *(v4u*)(R + off + bj * HALF) = o; } }
    }
};

template <class Epi, class Sched, bool GATHER = false, bool RAGGED = false>
__device__ __forceinline__ void gemm_phase(LAS unsigned char* lds, const Gemm g, const Sched& S, const Epi& E) {
    int tid_ = threadIdx.x; asm volatile("" : "+v"(tid_));
    const int tid = tid_, wid = __builtin_amdgcn_readfirstlane(tid >> 6), lane = tid & 63, wr = wid >> 2, wc = wid & 3, fr = lane & 15, fq = lane >> 4;
    const int K = g.K, nt = K / BK;
    unsigned voffA[2], voffB[2]; int RA[2], CA[2];
#pragma unroll
    for (int i = 0; i < 2; ++i) { int R, C; stage_rc(tid * 16 + i * 8192, R, C); const int Rb = Epi::PERM ? ((R & ~31) + perm32(R & 31)) : R; RA[i] = R; CA[i] = C;
        voffA[i] = (unsigned)(R * g.lda + C) * 2u; voffB[i] = (unsigned)(Rb * g.ldb + C) * 2u; }
    const size_t kstep = (size_t)(BK * 2);
    const size_t hstepA = GATHER ? 0 : (size_t)HALF * g.lda * 2, hstepB = (size_t)HALF * g.ldb * 2;
    const unsigned ldsw = (unsigned)wid * 1024u;
    const int aoff = lds_byte(wr * 64 + fr, fq * 8), boff = lds_byte(wc * 32 + fr, fq * 8);
    unsigned gc[2][2], gn[2][2];
#define PG8_SA(b, h) (((b) * 2 + (h)) * HTB)
#define PG8_SB(b, h) ((4 + (b) * 2 + (h)) * HTB)
#define PG8_GLDS(bufoff, gptr, i_) __builtin_amdgcn_global_load_lds((const unsigned*)(gptr), (LAS unsigned*)(lds + (bufoff) + ldsw + (i_) * 8192), 16, 0, 0)
#define PG8_STAGEB(bufoff, gbase) do { PG8_GLDS(bufoff, (const char*)(gbase) + voffB[0], 0); PG8_GLDS(bufoff, (const char*)(gbase) + voffB[1], 1); } while (0)
#define PG8_STAGEA(bufoff, kp, h, nx) do { if constexpr (GATHER) { const unsigned o0 = (nx) ? gn[h][0] : gc[h][0], o1 = (nx) ? gn[h][1] : gc[h][1]; \
            PG8_GLDS(bufoff, (const char*)(kp) + o0, 0); PG8_GLDS(bufoff, (const char*)(kp) + o1, 1); } \
        else { PG8_GLDS(bufoff, (const char*)(kp) + (h) * hstepA + voffA[0], 0); PG8_GLDS(bufoff, (const char*)(kp) + (h) * hstepA + voffA[1], 1); } } while (0)
#define PG8_LDA(dst, b, h) do { _Pragma("unroll") for (int m = 0; m < 4; ++m) _Pragma("unroll") for (int k = 0; k < 2; ++k) dst[m][k] = *(const LAS bf16x8*)(lds + PG8_SA(b, h) + aoff + m * 2048 + k * 1024); } while (0)
#define PG8_LDB(dst, b, h) do { _Pragma("unroll") for (int n = 0; n < 2; ++n) _Pragma("unroll") for (int k = 0; k < 2; ++k) dst[n][k] = *(const LAS bf16x8*)(lds + PG8_SB(b, h) + boff + n * 2048 + k * 1024); } while (0)
#define PG8_MMA(ai, bj, At, Bt) do { __builtin_amdgcn_s_setprio(1); _Pragma("unroll") for (int m = 0; m < 4; ++m) _Pragma("unroll") for (int n = 0; n < 2; ++n) _Pragma("unroll") for (int k = 0; k < 2; ++k) \
        acc[ai][bj][m][n] = __builtin_amdgcn_mfma_f32_16x16x32_bf16(Bt[n][k], At[m][k], acc[ai][bj][m][n], 0, 0, 0); __builtin_amdgcn_s_setprio(0); } while (0)
#define PG8_WAIT_V(n) asm volatile("s_waitcnt vmcnt(" #n ")" ::: "memory")
#define PG8_WAIT_L(n) asm volatile("s_waitcnt lgkmcnt(" #n ")" ::: "memory")
#define PG8_BAR __builtin_amdgcn_s_barrier()
#define PG8_SCHED __builtin_amdgcn_sched_barrier(0)
#define PG8_GOFF(dst, u) do { _Pragma("unroll") for (int h_ = 0; h_ < 2; ++h_) _Pragma("unroll") for (int i_ = 0; i_ < 2; ++i_) { const int e_ = h_ * HALF + RA[i_]; \
        const int tok_ = (e_ < (u).nrows) ? (u).rows[e_] : 0; dst[h_][i_] = (unsigned)(tok_ * g.lda + CA[i_]) * 2u; } } while (0)
    Unit cur, nxt; int ui = 0;
    if (!S.next(0, cur)) return;
    f32x4 acc[2][2][4][2];
#pragma unroll
    for (int a = 0; a < 2; ++a)
#pragma unroll
        for (int b = 0; b < 2; ++b)
#pragma unroll
            for (int m = 0; m < 4; ++m)
#pragma unroll
                for (int n = 0; n < 2; ++n) acc[a][b][m][n] = (f32x4){0.f, 0.f, 0.f, 0.f};
    bf16x8 At[4][2], B0[2][2], B1[2][2];
    const char* cA = cur.a; const char* cB = cur.b;
    S.ready_first(cur);
    if constexpr (GATHER) { PG8_GOFF(gc, cur); VM_WAIT(); }
    PG8_STAGEB(PG8_SB(0, 0), cB); PG8_STAGEB(PG8_SB(0, 1), cB + hstepB); PG8_STAGEA(PG8_SA(0, 0), cA, 0, false); PG8_STAGEA(PG8_SA(0, 1), cA, 1, false);
    if (wr == 1) PG8_BAR;
    PG8_WAIT_V(2); PG8_BAR;
    PG8_STAGEB(PG8_SB(1, 0), cB + kstep); PG8_STAGEA(PG8_SA(1, 0), cA + kstep, 0, false); PG8_STAGEB(PG8_SB(1, 1), cB + hstepB + kstep);
    PG8_WAIT_V(6); PG8_BAR;
    for (;;) {
        const bool has_next = S.next(ui + 1, nxt);
        const bool act0 = !RAGGED || (wr * 64 < cur.nrows), act1 = !RAGGED || (HALF + wr * 64 < cur.nrows);
        if (has_next) S.ready(nxt);
        const char* nA = has_next ? nxt.a : cA; const char* nB = has_next ? nxt.b : cB;
        if constexpr (GATHER) { if (has_next) { PG8_GOFF(gn, nxt); } else { _Pragma("unroll") for (int h_ = 0; h_ < 2; ++h_) _Pragma("unroll") for (int i_ = 0; i_ < 2; ++i_) gn[h_][i_] = gc[h_][i_]; }
            VM_WAIT(); }
        for (int t = 0; t < nt; t += 2) {
            const bool last = (t == nt - 2);
            const char* a1 = cA + (size_t)(t + 1) * kstep;
            const char* a2 = last ? nA : cA + (size_t)(t + 2) * kstep; const char* b2 = last ? nB : cB + (size_t)(t + 2) * kstep;
            const char* a3 = a2 + kstep; const char* b3 = b2 + kstep;
            if (act0) { PG8_LDB(B0, 0, 0); PG8_LDB(B1, 0, 1); PG8_SCHED; PG8_LDA(At, 0, 0); } PG8_STAGEA(PG8_SA(1, 1), a1, 1, false);
            PG8_WAIT_V(8); PG8_WAIT_L(0); PG8_BAR; if (act0) { PG8_MMA(0, 0, At, B0); PG8_MMA(0, 1, At, B1); } PG8_BAR; PG8_SCHED;
            if (act1) { PG8_LDA(At, 0, 1); } PG8_STAGEB(PG8_SB(0, 0), b2); PG8_STAGEB(PG8_SB(0, 1), b2 + hstepB); PG8_STAGEA(PG8_SA(0, 0), a2, 0, last);
            PG8_WAIT_V(8); PG8_WAIT_L(0); PG8_BAR; if (act1) { PG8_MMA(1, 0, At, B0); PG8_MMA(1, 1, At, B1); } PG8_BAR; PG8_SCHED;
            if (act0) { PG8_LDB(B0, 1, 0); PG8_LDB(B1, 1, 1); PG8_SCHED; PG8_LDA(At, 1, 0); } PG8_STAGEA(PG8_SA(0, 1), a2, 1, last);
            PG8_WAIT_V(8); PG8_WAIT_L(0); PG8_BAR; if (act0) { PG8_MMA(0, 0, At, B0); PG8_MMA(0, 1, At, B1); } PG8_BAR; PG8_SCHED;
            if (act1) { PG8_LDA(At, 1, 1); } PG8_STAGEB(PG8_SB(1, 0), b3); PG8_STAGEB(PG8_SB(1, 1), b3 + hstepB); PG8_STAGEA(PG8_SA(1, 0), a3, 0, last);
            PG8_WAIT_V(8); PG8_WAIT_L(0); PG8_BAR; if (act1) { PG8_MMA(1, 0, At, B0); PG8_MMA(1, 1, At, B1); } PG8_BAR; PG8_SCHED;
        }
        if (wr == 0) PG8_BAR;
        E(acc, cur, wr, wc, fr, fq);
        S.done(cur);
        if (!has_next) break;
#pragma unroll
        for (int a = 0; a < 2; ++a)
#pragma unroll
            for (int b = 0; b < 2; ++b)
#pragma unroll
                for (int m = 0; m < 4; ++m)
#pragma unroll
                    for (int n = 0; n < 2; ++n) acc[a][b][m][n] = (f32x4){0.f, 0.f, 0.f, 0.f};
        cur = nxt; cA = nA; cB = nB; ++ui;
        if constexpr (GATHER) { _Pragma("unroll") for (int h_ = 0; h_ < 2; ++h_) _Pragma("unroll") for (int i_ = 0; i_ < 2; ++i_) gc[h_][i_] = gn[h_][i_]; }
        if (wr == 1) PG8_BAR;
    }
    PG8_WAIT_V(0);
    PG8_BAR;
#undef PG8_SA
#undef PG8_SB
#undef PG8_GLDS
#undef PG8_STAGEA
#undef PG8_STAGEB
#undef PG8_LDA
#undef PG8_LDB
#undef PG8_MMA
#undef PG8_WAIT_V
#undef PG8_WAIT_L
#undef PG8_BAR
#undef PG8_SCHED
#undef PG8_GOFF
}
}

constexpr size_t MiB = 1u << 20;
constexpr size_t WS_CTL = 0;
constexpr size_t CTL_ZERO_BYTES = 64 * 1024;
constexpr size_t WS_SMALL = 1 * MiB;
constexpr size_t WS_WA_IN = 8 * MiB;
constexpr size_t WS_WA_OUT = WS_WA_IN + 4 * MiB;
constexpr size_t WS_WB_IN = WS_WA_OUT + 2 * MiB;
constexpr size_t WS_WB_COMB = WS_WB_IN + 6 * MiB;
constexpr size_t WS_WBQ = WS_WB_COMB + 4 * MiB;
constexpr size_t WS_WBOUT = WS_WBQ + 2 * MiB;
constexpr size_t WS_WUK = WS_WBOUT + 2 * MiB;
constexpr size_t WS_WUV = WS_WUK + MiB / 2;
constexpr size_t WS_WE_IN = WS_WUV + MiB / 2;
constexpr size_t WS_WE_OUT = WS_WE_IN + 64 * MiB;
constexpr size_t WS_WP = WS_WE_OUT + 32 * MiB;
constexpr size_t WS_WG = WS_WP + 1 * MiB;
constexpr size_t WS_WEND = WS_WG + 4 * MiB;
static_assert(WS_WEND == 130 * MiB, "weights map");
constexpr size_t WS_PB = 130 * MiB;
constexpr size_t WS_A = 146 * MiB;
constexpr size_t WS_B = 178 * MiB;
constexpr size_t WS_C = 242 * MiB;
constexpr size_t WS_D = 306 * MiB;
constexpr size_t WS_E = 330 * MiB;
constexpr size_t WS_F = 414 * MiB;
constexpr size_t WS_G = 478 * MiB;
constexpr size_t WS_END = 510 * MiB;
constexpr size_t WS_KF = WS_G + 16 * MiB;

constexpr size_t WS_LIST = WS_SMALL;
constexpr size_t WS_GLIST = WS_SMALL + 2 * MiB;
constexpr size_t WS_TOK2 = WS_SMALL + 4 * MiB;
constexpr size_t WS_RWT = WS_SMALL + 5 * MiB;
constexpr int CW_COUNTS = 12288;
constexpr int MAXTILES = 160;

#ifndef DUP_MASK
#define DUP_MASK 0
#endif
#ifndef P10_DUP_SCORE
#define P10_DUP_SCORE 0
#endif
#ifndef P10_DUP_SEL
#define P10_DUP_SEL 0
#endif
#ifndef P11_DUP_QK
#define P11_DUP_QK 0
#endif
#ifndef P11_DUP_WR
#define P11_DUP_WR 0
#endif
#ifndef P11_DUP_LD
#define P11_DUP_LD 0
#endif
#ifndef P4_DUP_ROUTER
#define P4_DUP_ROUTER 0
#endif
#ifndef BAR_DUP
#define BAR_DUP 0
#endif
#ifndef SEL_DUP_HIST
#define SEL_DUP_HIST 0
#endif
#ifndef SEL_DUP_EMIT
#define SEL_DUP_EMIT 0
#endif
#ifndef SEL_DUP_BIS
#define SEL_DUP_BIS 0
#endif
constexpr int NWAVES = 8;
constexpr int RING_BYTES = 131072;
constexpr int LDS_BYTES = 163840;
constexpr int XTRA_OFF = RING_BYTES;


#ifndef P5_NORAG
#define P5_NORAG 0
#endif
#ifndef P5_DUP_PW
#define P5_DUP_PW 0
#endif
#ifndef P5_DUP_MOE1
#define P5_DUP_MOE1 0
#endif
#define XB_TMO      128
#define XB_XCNT(j)  (256  + 64 * (j))
#define XB_XSUB(j)  (1280 + 64 * (j))
#define XB_XGEN(j)  (2304 + 64 * (j))
#define XB_TOP      3328
#define XB_TOPGEN   3392
#define XCD_BAR_WORDS 3456
#define XB_SPIN_CAP (1u << 22)
#if !defined(DUP_PHASE) && !defined(MK_PER_PHASE)
#define CTL_GLOBAL 1
__device__ unsigned g_ctl[16384];
#else
#define CTL_GLOBAL 0
#endif
constexpr int CW_DONE = 64;
__device__ __forceinline__ unsigned* ctl_words(unsigned char* ws) {
#if CTL_GLOBAL
    (void)ws; return g_ctl;
#else
    return (unsigned*)(ws + WS_CTL);
#endif
}
constexpr int CW_BAR = 1024;
constexpr int BAR_LDS_OFF = LDS_BYTES - 64;
__device__ __forceinline__ unsigned xb_ld(unsigned* p)              { return __hip_atomic_load(p, __ATOMIC_RELAXED, __HIP_MEMORY_SCOPE_AGENT); }
__device__ __forceinline__ unsigned xb_add(unsigned* p, unsigned v) { return __hip_atomic_fetch_add(p, v, __ATOMIC_RELAXED, __HIP_MEMORY_SCOPE_AGENT); }
__device__ __forceinline__ unsigned xb_xcc_id() { return (unsigned)__builtin_amdgcn_s_getreg((3 << 11) | 20) & 0xFu; }
#define XB_SPIN(cond, bar) do { unsigned _sp = 0; while (cond) { __builtin_amdgcn_s_sleep(1); \
    if ((++_sp & 255u) == 0u) { if (xb_ld(&(bar)[XB_TMO])) break; if (_sp > XB_SPIN_CAP) { atomicAdd(&(bar)[XB_TMO], 1u); break; } } } } while (0)
struct XcdBarrier { unsigned* bar; unsigned x; volatile LAS unsigned* st; };
__device__ __forceinline__ XcdBarrier xcd_barrier_post(unsigned* bar, volatile LAS unsigned* st) {
    XcdBarrier b; b.bar = bar; b.x = xb_xcc_id(); b.st = st;
    if (threadIdx.x == 0) (void)xb_add(&bar[XB_XCNT(b.x)], 1u);
    return b;
}
__device__ __forceinline__ void xcd_barrier_complete(unsigned* bar, unsigned x, unsigned& nloc, unsigned& nx) {
    const unsigned G = gridDim.x * gridDim.y * gridDim.z;
    unsigned sum, cnt, mine, sp = 0u;
    for (;;) {
        sum = 0u; cnt = 0u; mine = 0u;
#pragma unroll
        for (unsigned j = 0; j < 16; ++j) { const unsigned c = xb_ld(&bar[XB_XCNT(j)]); sum += c; cnt += (c > 0u) ? 1u : 0u; mine = (j == x) ? c : mine; }
        if (sum == G) break;
        __builtin_amdgcn_s_sleep(1);
        if ((++sp & 255u) == 0u) { if (xb_ld(&bar[XB_TMO])) break; if (sp > XB_SPIN_CAP) { atomicAdd(&bar[XB_TMO], 1u); break; } }
    }
    nloc = mine > 0u ? mine : 1u; nx = cnt > 0u ? cnt : 1u;
}
__device__ __forceinline__ void xcd_barrier(const XcdBarrier& b) {
    asm volatile("s_waitcnt vmcnt(0)" ::: "memory");
    __syncthreads();
    if (threadIdx.x == 0) {
        unsigned* bar = b.bar;
        __builtin_amdgcn_s_waitcnt(0);
        unsigned nloc = b.st[0], nx = b.st[1];
        if (nloc == 0u) { xcd_barrier_complete(bar, b.x, nloc, nx); b.st[0] = nloc; b.st[1] = nx; }
        const unsigned old = xb_add(&bar[XB_XSUB(b.x)], 1u);
        const unsigned gen = old / nloc;
        if (old + 1u == (gen + 1u) * nloc) {
            __builtin_amdgcn_fence(__ATOMIC_RELEASE, "agent");
            asm volatile("s_waitcnt vmcnt(0)" ::: "memory");
            const unsigned og = xb_add(&bar[XB_TOP], 1u);
            const unsigned tg = og / nx;
            if (og + 1u == (tg + 1u) * nx) xb_add(&bar[XB_TOPGEN], 1u);
            else XB_SPIN(xb_ld(&bar[XB_TOPGEN]) == tg, bar);
            __builtin_amdgcn_fence(__ATOMIC_ACQUIRE, "agent");
            xb_add(&bar[XB_XGEN(b.x)], 1u);
            asm volatile("s_waitcnt vmcnt(0)" ::: "memory");
        } else {
            XB_SPIN(xb_ld(&bar[XB_XGEN(b.x)]) == gen, bar);
            __builtin_amdgcn_fence(__ATOMIC_ACQUIRE, "agent");
            asm volatile("s_waitcnt vmcnt(0)" ::: "memory");
        }
    }
    __syncthreads();
}

struct Args { const float* in[27]; float* out; unsigned char* ws; int ph_lo, ph_hi, li, pad; };

struct Frame {
    LAS unsigned char* lds;
    int wave, vcu, G;
    unsigned char* ws;
};

__device__ __forceinline__ void cvt_t_item(const float* src, int ldsrc, int k0, int n0, int nvalid, bf16* dst, int ldk, int drow0, LAS float* scr, int lane) {
    const int nn = 4 * (lane & 15), kq = lane >> 4;
    if (n0 + 64 <= nvalid) {
#pragma unroll
        for (int i = 0; i < 16; ++i) { const int k = kq + 4 * i; const f32x4 v = __builtin_nontemporal_load((const f32x4*)(src + (size_t)(k0 + k) * ldsrc + n0 + nn));
            scr[k * 65 + nn + 0] = v[0]; scr[k * 65 + nn + 1] = v[1]; scr[k * 65 + nn + 2] = v[2]; scr[k * 65 + nn + 3] = v[3]; }
    } else {
#pragma unroll
        for (int i = 0; i < 16; ++i) { const int k = kq + 4 * i;
#pragma unroll
            for (int e = 0; e < 4; ++e) scr[k * 65 + nn + e] = (n0 + nn + e < nvalid) ? src[(size_t)(k0 + k) * ldsrc + n0 + nn + e] : 0.f; }
    }
    LDS_WAIT(); asm volatile("" ::: "memory");
    const int kc = lane & 7;
#pragma unroll
    for (int jj = 0; jj < 8; ++jj) { const int n = (lane >> 3) + 8 * jj; const LAS float* s = scr + (8 * kc) * 65 + n;
        v4u o; o.x = pk2(s[0 * 65], s[1 * 65]); o.y = pk2(s[2 * 65], s[3 * 65]); o.z = pk2(s[4 * 65], s[5 * 65]); o.w = pk2(s[6 * 65], s[7 * 65]);
        *(v4u*)(dst + (size_t)(drow0 + n) * ldk + k0 + 8 * kc) = o; }
    LDS_WAIT(); asm volatile("" ::: "memory");
}
__device__ __forceinline__ void cvt_rows(const float* src, int ldsrc, bf16* dst, int ldd, int rows, int cols, int gw, int NGW, int lane) {
    const int cpr = cols / 8, sh = 31 - __builtin_clz(cpr); const int total = rows * cpr;
    for (int i = gw * 64 + lane; i < total; i += NGW * 64) { const int r = i >> sh; const int c = (i & (cpr - 1)) * 8;
        const f32x4 a = __builtin_nontemporal_load((const f32x4*)(src + (size_t)r * ldsrc + c)), b = __builtin_nontemporal_load((const f32x4*)(src + (size_t)r * ldsrc + c + 4));
        v4u o; o.x = pk2(a[0], a[1]); o.y = pk2(a[2], a[3]); o.z = pk2(b[0], b[1]); o.w = pk2(b[2], b[3]);
        *(v4u*)(dst + (size_t)r * ldd + c) = o; }
}
__device__ __forceinline__ void p0_convert(Frame& F, const Args& args) {
    LAS float* scr = (LAS float*)(F.lds + F.wave * 16640);
    const int gw = F.vcu * NWAVES + F.wave, NGW = F.G * NWAVES;
    unsigned char* ws = F.ws;
    constexpr int I0 = 16 * 32, I1 = 16 * 16, I2 = 16 * 14, I3 = 16 * 16, I4 = 64 * 128, I5 = 64 * 64, I6 = 2 * 64, I7 = 2 * 256;
    constexpr int NIT = I0 + I1 + I2 + I3 + I4 + I5 + I6 + I7;
    for (int it = gw; it < NIT; it += NGW) {
        int r = it;
        if (r < I0) { const int kb = r / 32, nb = r % 32; cvt_t_item(args.in[2], 2048, kb * 64, nb * 64, 2048, (bf16*)(ws + WS_WA_IN), 1024, nb * 64, scr, ((int)threadIdx.x & 63)); continue; } r -= I0;
        if (r < I1) { const int kb = r / 16, nb = r % 16; cvt_t_item(args.in[8], 1024, kb * 64, nb * 64, 1024, (bf16*)(ws + WS_WA_OUT), 1024, nb * 64, scr, ((int)threadIdx.x & 63)); continue; } r -= I1;
        if (r < I2) { const int kb = r / 14, nb = r % 14; cvt_t_item(args.in[9] + 1024, PROJ_B, kb * 64, nb * 64, PROJ_B - 1024, (bf16*)(ws + WS_WB_IN), 1024, 2048 + nb * 64, scr, ((int)threadIdx.x & 63)); continue; } r -= I2;
        if (r < I3) { const int kb = r / 16, nb = r % 16; cvt_t_item(args.in[13], 1024, kb * 64, nb * 64, 1024, (bf16*)(ws + WS_WBOUT), 1024, nb * 64, scr, ((int)threadIdx.x & 63)); continue; } r -= I3;
        if (r < I4) { const int e = r / 128, q = r % 128, kb = q / 8, nb = q % 8; const int n0 = nb * 64, half = n0 >> 8, rem = n0 & 255, pn = rem >> 7, j0 = rem & 127;
            if (e >= 32) continue;
            cvt_t_item(args.in[22] + (size_t)e * 1024 * 512, 512, kb * 64, n0, 512, (bf16*)(ws + WS_WE_IN) + (size_t)e * 512 * 1024, 1024, pn * 256 + half * 128 + j0, scr, ((int)threadIdx.x & 63)); continue; } r -= I4;
        if (r < I5) { const int e = r / 64, q = r % 64, kb = q / 16, nb = q % 16;
            if (e >= 32) continue;
            cvt_t_item(args.in[23] + (size_t)e * 256 * 1024, 1024, kb * 64, nb * 64, 1024, (bf16*)(ws + WS_WE_OUT) + (size_t)e * 1024 * 256, 256, nb * 64, scr, ((int)threadIdx.x & 63)); continue; } r -= I5;
        if (r < I6) { const int l = r / 64, q = r % 64, kb = q / 16, nb = q % 16;
            if (l >= 1) continue;
            cvt_t_item(args.in[24] + (size_t)l * 256 * 1024, 1024, kb * 64, nb * 64, 1024, (bf16*)(ws + WS_WP) + (size_t)l * 1024 * 256, 256, nb * 64, scr, ((int)threadIdx.x & 63)); continue; } r -= I6;
        { const int l = r / 256, q = r % 256, kb = q / 16, nb = q % 16;
            if (l >= 1) continue;
            cvt_t_item(args.in[25] + (size_t)l * 1024 * 1024, 1024, kb * 64, nb * 64, 1024, (bf16*)(ws + WS_WG) + (size_t)l * 1024 * 1024, 1024, nb * 64, scr, ((int)threadIdx.x & 63)); }
    }
    cvt_rows(args.in[0], 1024, (bf16*)(ws + WS_C), 1024, T, 1024, gw, NGW, ((int)threadIdx.x & 63));
    cvt_rows(args.in[1], 256, (bf16*)(ws + WS_PB), 256, 2 * T, 256, gw, NGW, ((int)threadIdx.x & 63));
    cvt_rows(args.in[11], 128, (bf16*)(ws + WS_WUK), 128, 8 * 256, 128, gw, NGW, ((int)threadIdx.x & 63));
    cvt_rows(args.in[12], 128, (bf16*)(ws + WS_WUV), 128, 8 * 256, 128, gw, NGW, ((int)threadIdx.x & 63));
    cvt_rows(args.in[9], PROJ_B, (bf16*)(ws + WS_WBQ), 1024, 1024, 1024, gw, NGW, ((int)threadIdx.x & 63));
    { float* RWT = (float*)(ws + WS_RWT);
      for (int i = gw * 64 + ((int)threadIdx.x & 63); i < 2 * 36 * 1024; i += NGW * 64) { const int L = i / (36 * 1024), j = (i / 1024) % 36, c = i % 1024;
          RWT[i] = (j < 4) ? args.in[18][(size_t)L * 4096 + c * 4 + j] : args.in[20][(size_t)L * 32768 + c * 32 + (j - 4)]; } }
    { v4u z = {0u, 0u, 0u, 0u}; v4u* d = (v4u*)((bf16*)(ws + WS_WB_IN) + (size_t)2944 * 1024);
      for (int i = gw * 64 + ((int)threadIdx.x & 63); i < 128 * 1024 / 8; i += NGW * 64) d[i] = z; }
}


__device__ __forceinline__ void cvt_late(Frame& F, const Args& args, int slot, int nslots) {
    LAS float* scr = (LAS float*)(F.lds + F.wave * 16640); unsigned char* ws = F.ws; const int lane = ((int)threadIdx.x & 63);
    for (int it = slot; it < 32 * 128 + 32 * 64 + 64 + 256; it += nslots) {
        if (it < 32 * 128) { const int e = 32 + it / 128, q = it % 128, kb = q / 8, nb = q % 8; const int n0 = nb * 64, half = n0 >> 8, rem = n0 & 255, pn = rem >> 7, j0 = rem & 127;
            cvt_t_item(args.in[22] + (size_t)e * 1024 * 512, 512, kb * 64, n0, 512, (bf16*)(ws + WS_WE_IN) + (size_t)e * 512 * 1024, 1024, pn * 256 + half * 128 + j0, scr, lane); }
        else if (it < 32 * 128 + 32 * 64) { const int r = it - 32 * 128; const int e = 32 + r / 64, q = r % 64, kb = q / 16, nb = q % 16;
            cvt_t_item(args.in[23] + (size_t)e * 256 * 1024, 1024, kb * 64, nb * 64, 1024, (bf16*)(ws + WS_WE_OUT) + (size_t)e * 1024 * 256, 256, nb * 64, scr, lane); }
        else if (it < 32 * 128 + 32 * 64 + 64) { const int q = it - (32 * 128 + 32 * 64), kb = q / 16, nb = q % 16;
            cvt_t_item(args.in[24] + (size_t)256 * 1024, 1024, kb * 64, nb * 64, 1024, (bf16*)(ws + WS_WP) + (size_t)1024 * 256, 256, nb * 64, scr, lane); }
        else { const int q = it - (32 * 128 + 32 * 64 + 64), kb = q / 16, nb = q % 16;
            cvt_t_item(args.in[25] + (size_t)1024 * 1024, 1024, kb * 64, nb * 64, 1024, (bf16*)(ws + WS_WG) + (size_t)1024 * 1024, 1024, nb * 64, scr, lane); }
    }

}

__device__ __forceinline__ unsigned off_b(unsigned row, unsigned ch) { return 256u * row + 16u * (ch ^ (((row & 3) << 2) | ((row >> 2) & 3))); }
__device__ __forceinline__ unsigned row_read_addr_16(unsigned lane, unsigned rb, unsigned s) { return off_b((lane & 15) + 16 * rb, 4 * s + (lane >> 4)); }
__device__ __forceinline__ unsigned tr_read_addr_16(unsigned lane, unsigned c, unsigned ks, unsigned t) {
    const unsigned g = lane >> 4, q = (lane & 15) >> 2, p = lane & 3;
    return off_b(32 * ks + 8 * g + 4 * t + q, 2 * c + (p >> 1)) + 8 * (p & 1);
}
__device__ __forceinline__ bf16x4 tr_read(LAS unsigned char* p) { return __builtin_amdgcn_ds_read_tr16_b64_v4i16((LAS bf16x4*)p); }
__device__ __forceinline__ float wave_sum(float v) {
#pragma unroll
    for (int o = 1; o < 64; o <<= 1) v += __shfl_xor(v, o);
    return v;
}


__device__ __forceinline__ float dpp_xor1(float x) { return __int_as_float(__builtin_amdgcn_update_dpp(0, __float_as_int(x), 0xB1, 0xf, 0xf, true)); }
__device__ __forceinline__ float dpp_xor2(float x) { return __int_as_float(__builtin_amdgcn_update_dpp(0, __float_as_int(x), 0x4E, 0xf, 0xf, true)); }
__device__ __forceinline__ float dpp_xor4(float x, bool b2) { const float up = __int_as_float(__builtin_amdgcn_update_dpp(0, __float_as_int(x), 0x104, 0xf, 0xf, true)),
        dn = __int_as_float(__builtin_amdgcn_update_dpp(0, __float_as_int(x), 0x114, 0xf, 0xf, true)); return b2 ? dn : up; }
__device__ __forceinline__ float dpp_xor8(float x) { return __int_as_float(__builtin_amdgcn_update_dpp(0, __float_as_int(x), 0x128, 0xf, 0xf, true)); }
__device__ __forceinline__ float xg_max(float x) {
    auto r = __builtin_amdgcn_permlane16_swap(__float_as_uint(x), __float_as_uint(x), false, false); x = fmaxf(__uint_as_float(r[0]), __uint_as_float(r[1]));
    auto q = __builtin_amdgcn_permlane32_swap(__float_as_uint(x), __float_as_uint(x), false, false); return fmaxf(__uint_as_float(q[0]), __uint_as_float(q[1]));
}
__device__ __forceinline__ float xg_sum(float x) {
    auto r = __builtin_amdgcn_permlane16_swap(__float_as_uint(x), __float_as_uint(x), false, false); x = __uint_as_float(r[0]) + __uint_as_float(r[1]);
    auto q = __builtin_amdgcn_permlane32_swap(__float_as_uint(x), __float_as_uint(x), false, false); return __uint_as_float(q[0]) + __uint_as_float(q[1]);
}
__device__ __forceinline__ float wave_sum_fast(float v) { v += dpp_xor1(v); v += dpp_xor2(v); v += dpp_xor4(v, ((int)threadIdx.x & 4) != 0); v += dpp_xor8(v); return xg_sum(v); }

__device__ __forceinline__ void p2_spatial(Frame& F, const Args& args) {
    unsigned char* ws = F.ws;
    const bf16* UV = (const bf16*)(ws + WS_B); bf16* GT = (bf16*)(ws + WS_A);
    const float* vn_g = args.in[4]; const float* vn_b = args.in[5]; const float* w_s = args.in[6]; const float* b_s = args.in[7];
    LAS unsigned char* VIMG = F.lds; LAS unsigned char* WIMG = F.lds + 32768; LAS f32x2* STATS = (LAS f32x2*)(F.lds + 65536); LAS float* RS = (LAS float*)(F.lds + 65536 + 1024);
    const int lane = ((int)threadIdx.x & 63), w = F.wave, tid = ((int)threadIdx.x);
    const int srow = tid >> 2, q4 = tid & 3;
    for (int unit = F.vcu; unit < 256; unit += F.G) {
        const int chunk = unit >> 1, half = unit & 1; const size_t t0 = (size_t)chunk * 128;
        { v4u ra[16], rb[16];
#pragma unroll
          for (int r = 0; r < 16; ++r) { const v4u* vp = (const v4u*)(UV + (t0 + 16 * w + r) * 2048 + 1024 + lane * 16); ra[r] = vp[0]; rb[r] = vp[1]; }
#pragma unroll
          for (int r = 0; r < 16; ++r) { float s = 0.f, q = 0.f;
#pragma unroll
              for (int e = 0; e < 4; ++e) { const float x0 = bflo(ra[r][e]), x1 = bfhi(ra[r][e]), x2 = bflo(rb[r][e]), x3 = bfhi(rb[r][e]); s += (x0 + x1) + (x2 + x3); q += (x0 * x0 + x1 * x1) + (x2 * x2 + x3 * x3); }
              s = wave_sum_fast(s); q = wave_sum_fast(q);
              const float mean = s * (1.f / 1024.f); const float var = fmaxf(q * (1.f / 1024.f) - mean * mean, 0.f);
              if (lane == 0) STATS[16 * w + r] = (f32x2){mean, rsqrtf(var + 1e-5f)}; } }
        v4u va[4]; f32x4 wa[4], wb[4];
#define P2_RAW(g_) do { _Pragma("unroll") for (int c4 = 0; c4 < 4; ++c4) { const int ch_ = q4 + 4 * c4; va[c4] = *(const v4u*)(UV + (t0 + srow) * 2048 + 1024 + (g_) * 128 + 8 * ch_); \
            const float* wp_ = w_s + ((size_t)(g_) * 128 + srow) * 128 + 8 * ch_; wa[c4] = *(const f32x4*)wp_; wb[c4] = *(const f32x4*)(wp_ + 4); } } while (0)
        P2_RAW(half * 4);
        __syncthreads();
        for (int gi = 0; gi < 4; ++gi) {
            const int g = half * 4 + gi;
            { const f32x2 st = STATS[srow]; float wsum = 0.f;
#pragma unroll
              for (int c4 = 0; c4 < 4; ++c4) { const int ch = q4 + 4 * c4; const v4u a = va[c4];
                  v4u o;
                  o.x = pk2((bflo(a.x) - st.x) * st.y, (bfhi(a.x) - st.x) * st.y); o.y = pk2((bflo(a.y) - st.x) * st.y, (bfhi(a.y) - st.x) * st.y);
                  o.z = pk2((bflo(a.z) - st.x) * st.y, (bfhi(a.z) - st.x) * st.y); o.w = pk2((bflo(a.w) - st.x) * st.y, (bfhi(a.w) - st.x) * st.y);
                  { const int pc = 4 * (ch >> 2) + ((ch & 3) >> 1); *(LAS v2u*)(VIMG + off_b(srow, pc) + 8 * (ch & 1)) = (v2u){o.x, o.y}; *(LAS v2u*)(VIMG + off_b(srow, pc + 2) + 8 * (ch & 1)) = (v2u){o.z, o.w}; }
                  const int s0 = 8 * ch; float m[8];
#pragma unroll
                  for (int e = 0; e < 4; ++e) { m[e] = (s0 + e <= srow) ? wa[c4][e] : 0.f; m[4 + e] = (s0 + 4 + e <= srow) ? wb[c4][e] : 0.f; }
                  v4u ow; ow.x = pk2(m[0], m[1]); ow.y = pk2(m[2], m[3]); ow.z = pk2(m[4], m[5]); ow.w = pk2(m[6], m[7]);
                  wsum += (bflo(ow.x) + bfhi(ow.x)) + (bflo(ow.y) + bfhi(ow.y)) + (bflo(ow.z) + bfhi(ow.z)) + (bflo(ow.w) + bfhi(ow.w));
                  *(LAS v4u*)(WIMG + off_b(srow, ch)) = ow; }
              wsum += dpp_xor1(wsum); wsum += dpp_xor2(wsum);
              if (q4 == 0) RS[srow] = wsum; }
            __syncthreads();
            if (gi < 3) P2_RAW(g + 1);
            const int wd = w >> 1, wt = w & 1;
            v4u uu[4]; float bs[4], rsv[4]; f32x4 gd[2], bd[2];
            const int dcol8 = g * 128 + 32 * wd + 8 * (lane >> 4);
#pragma unroll
            for (int dt = 0; dt < 2; ++dt) { gd[dt] = *(const f32x4*)(vn_g + dcol8 + 4 * dt); bd[dt] = *(const f32x4*)(vn_b + dcol8 + 4 * dt); }
#pragma unroll
            for (int tb = 0; tb < 4; ++tb) { const int tl = 64 * wt + 16 * tb + (lane & 15); bs[tb] = b_s[g * 128 + tl]; rsv[tb] = RS[tl];
                uu[tb] = *(const v4u*)(UV + (t0 + tl) * 2048 + dcol8); }
            f32x4 acc[2][4];
#pragma unroll
            for (int i = 0; i < 2; ++i)
#pragma unroll
                for (int j = 0; j < 4; ++j) acc[i][j] = (f32x4){0.f, 0.f, 0.f, 0.f};
            const int nks = wt ? 4 : 2;
            for (int ks = 0; ks < nks; ++ks) {
                bf16x8 Af[2], Bf[4];
#pragma unroll
                for (int dt = 0; dt < 2; ++dt) { const bf16x4 lo = tr_read(VIMG + tr_read_addr_16(lane, 2 * wd + dt, ks, 0)), hi = tr_read(VIMG + tr_read_addr_16(lane, 2 * wd + dt, ks, 1));
                    Af[dt] = (bf16x8){lo[0], lo[1], lo[2], lo[3], hi[0], hi[1], hi[2], hi[3]}; }
#pragma unroll
                for (int tb = 0; tb < 4; ++tb) Bf[tb] = *(const LAS bf16x8*)(WIMG + row_read_addr_16(lane, 4 * wt + tb, ks));
#pragma unroll
                for (int dt = 0; dt < 2; ++dt)
#pragma unroll
                    for (int tb = 0; tb < 4; ++tb) acc[dt][tb] = __builtin_amdgcn_mfma_f32_16x16x32_bf16(Af[dt], Bf[tb], acc[dt][tb], 0, 0, 0);
            }
#pragma unroll
            for (int tb = 0; tb < 4; ++tb) { const size_t t = t0 + 64 * wt + 16 * tb + (lane & 15); const v4u u = uu[tb];
                const f32x4 s0 = acc[0][tb] * gd[0] + bd[0] * rsv[tb] + bs[tb], s1 = acc[1][tb] * gd[1] + bd[1] * rsv[tb] + bs[tb];
                v4u o; o.x = pk2(bflo(u.x) * s0[0], bfhi(u.x) * s0[1]); o.y = pk2(bflo(u.y) * s0[2], bfhi(u.y) * s0[3]); o.z = pk2(bflo(u.z) * s1[0], bfhi(u.z) * s1[1]); o.w = pk2(bflo(u.w) * s1[2], bfhi(u.w) * s1[3]);
                *(v4u*)(GT + t * 1024 + dcol8) = o; }
            __syncthreads();
        }
#undef P2_RAW
    }
}


struct MoeTab { LAS int* tpre; LAS int* cnt; LAS int* tile_e; LAS int* nt; LAS int* ord; LAS int* spre; };
__device__ __forceinline__ MoeTab moe_tab(Frame& F) { LAS int* b = (LAS int*)(F.lds + XTRA_OFF); MoeTab t; t.tpre = b; t.cnt = b + 64; t.tile_e = b + 128; t.nt = b + 320; t.ord = b + 336; t.spre = b + 512; return t; }
__device__ __forceinline__ int wave_scan_i(int v);
__device__ __forceinline__ void moe_tab_build(Frame& F, int L) {
    MoeTab t = moe_tab(F); const unsigned* counts = ctl_words(F.ws) + CW_COUNTS + 32 * L;
    __syncthreads();
    if (F.wave == 0) {
        int lane = (int)threadIdx.x; asm volatile("" : "+v"(lane));
        const int c = lane < 32 ? (int)__hip_atomic_load(counts + lane, __ATOMIC_RELAXED, __HIP_MEMORY_SCOPE_AGENT) : 0;
        const int nte = (c + 255) >> 8, sh = (c > 0 && ((c - 1) & 255) < 128) ? 1 : 0;
        const int incl = wave_scan_i(nte), sincl = wave_scan_i(sh);
        const int tp = incl - nte, sp = sincl - sh;
        const int nt = __builtin_amdgcn_readlane(incl, 63), nfull = nt - __builtin_amdgcn_readlane(sincl, 63);
        if (lane < 32) { t.cnt[lane] = c; t.tpre[lane] = tp; t.spre[lane] = sp; }
        if (lane == 32) { t.tpre[32] = tp; t.spre[32] = sp; t.nt[0] = nt; }
        for (int k = 0; k < nte; ++k) { const int m = tp + k; t.tile_e[m] = lane; const bool shortt = (k == nte - 1) && (sh != 0); t.ord[shortt ? nfull + sp : m - sp] = m; }
    }
    __syncthreads();
}

__device__ __forceinline__ void p4_ln_router(Frame& F, const Args& args, int L, const bf16* R, bf16* X1b) {
    unsigned char* ws = F.ws;
    const float* lng = args.in[14] + L * 1024; const float* lnb = args.in[15] + L * 1024;
    const float* bg = args.in[19] + L * 4; const float* be = args.in[21] + L * 32;
    const float* RWT = (const float*)(ws + WS_RWT) + (size_t)L * 36 * 1024;
    unsigned* gcount = ctl_words(ws) + CW_COUNTS + 32 * L;
    int* LIST = (int*)(ws + WS_LIST); float* GLIST = (float*)(ws + WS_GLIST); int* TOK2 = (int*)(ws + WS_TOK2);
    const int lane = ((int)threadIdx.x & 63), w = F.wave, tid = ((int)threadIdx.x);
    LAS float* LG = (LAS float*)(F.lds) + w * (8 * 40);
    LAS float* PE = (LAS float*)(F.lds + 16384) + w * 64;
    LAS int* RT_E = (LAS int*)(F.lds + 32768);
    LAS float* RT_G = (LAS float*)(F.lds + 32768 + 1024);
    LAS int* RT_P = (LAS int*)(F.lds + 32768 + 2048);
    LAS int* LCNT = (LAS int*)(F.lds + 32768 + 4096);
    LAS int* LBASE = (LAS int*)(F.lds + 32768 + 4096 + 256);
    for (int blk = F.vcu; blk < T / 64; blk += F.G) {
        const int rbase = blk * 64 + w * 8;
        f32x4 xv[8][4];
#define P4_COL(i_) (8 * lane + 512 * ((i_) >> 1) + 4 * ((i_) & 1))
        { v4u rb[8][2]; f32x4 gg[4], bb[4];
#pragma unroll
          for (int r = 0; r < 8; ++r)
#pragma unroll
              for (int i = 0; i < 2; ++i) rb[r][i] = __builtin_nontemporal_load((const v4u*)(R + (size_t)(rbase + r) * 1024 + 8 * lane + 512 * i));
#pragma unroll
          for (int i = 0; i < 4; ++i) { gg[i] = *(const f32x4*)(lng + P4_COL(i)); bb[i] = *(const f32x4*)(lnb + P4_COL(i)); }
#pragma unroll
          for (int r = 0; r < 8; ++r) { float s = 0.f;
#pragma unroll
              for (int i = 0; i < 4; ++i) { const unsigned w0 = (i & 1) ? rb[r][i >> 1].z : rb[r][i >> 1].x, w1 = (i & 1) ? rb[r][i >> 1].w : rb[r][i >> 1].y;
                  xv[r][i] = (f32x4){bflo(w0), bfhi(w0), bflo(w1), bfhi(w1)}; s += (xv[r][i][0] + xv[r][i][1]) + (xv[r][i][2] + xv[r][i][3]); }
              const float mean = wave_sum_fast(s) * (1.f / 1024.f); float q = 0.f;
#pragma unroll
              for (int i = 0; i < 4; ++i) { xv[r][i] = xv[r][i] - mean; q += (xv[r][i][0] * xv[r][i][0] + xv[r][i][1] * xv[r][i][1]) + (xv[r][i][2] * xv[r][i][2] + xv[r][i][3] * xv[r][i][3]); }
              const float rstd = rsqrtf(wave_sum_fast(q) * (1.f / 1024.f) + 1e-5f);
#pragma unroll
              for (int i = 0; i < 4; ++i) xv[r][i] = xv[r][i] * rstd * gg[i] + bb[i];
#pragma unroll
              for (int i = 0; i < 2; ++i) { v4u o; o.x = pk2(xv[r][2 * i][0], xv[r][2 * i][1]); o.y = pk2(xv[r][2 * i][2], xv[r][2 * i][3]); o.z = pk2(xv[r][2 * i + 1][0], xv[r][2 * i + 1][1]); o.w = pk2(xv[r][2 * i + 1][2], xv[r][2 * i + 1][3]);
                  *(v4u*)(X1b + (size_t)(rbase + r) * 1024 + 8 * lane + 512 * i) = o; } } }
        f32x4 wn[4];
#pragma unroll
        for (int i = 0; i < 4; ++i) wn[i] = *(const f32x4*)(RWT + P4_COL(i));
#define P4_DOT(dst, r_) do { f32x2 a2_ = {0.f, 0.f}; _Pragma("unroll") for (int i_ = 0; i_ < 4; ++i_) { \
            a2_ = __builtin_elementwise_fma((f32x2){xv[r_][i_][0], xv[r_][i_][1]}, (f32x2){wv[i_][0], wv[i_][1]}, a2_); \
            a2_ = __builtin_elementwise_fma((f32x2){xv[r_][i_][2], xv[r_][i_][3]}, (f32x2){wv[i_][2], wv[i_][3]}, a2_); } dst = a2_.x + a2_.y; } while (0)
#define P4_BFLY(n3_, v_) do { const bool b0_ = lane & 1, b1_ = lane & 2, b2_ = lane & 4; float n1_[4], n2_[2]; \
            _Pragma("unroll") for (int k_ = 0; k_ < 4; ++k_) { const float keep_ = b0_ ? v_[2 * k_ + 1] : v_[2 * k_], send_ = b0_ ? v_[2 * k_] : v_[2 * k_ + 1]; n1_[k_] = keep_ + dpp_xor1(send_); } \
            _Pragma("unroll") for (int m_ = 0; m_ < 2; ++m_) { const float keep_ = b1_ ? n1_[2 * m_ + 1] : n1_[2 * m_], send_ = b1_ ? n1_[2 * m_] : n1_[2 * m_ + 1]; n2_[m_] = keep_ + dpp_xor2(send_); } \
            { const float keep_ = b2_ ? n2_[1] : n2_[0], send_ = b2_ ? n2_[0] : n2_[1]; n3_ = keep_ + dpp_xor4(send_, b2_); } \
            n3_ += dpp_xor8(n3_); n3_ = xg_sum(n3_); } while (0)
        for (int j = 0; j < 4; ++j) {
            f32x4 wv[4];
#pragma unroll
            for (int i = 0; i < 4; ++i) wv[i] = wn[i];
            { const float* wp = RWT + (size_t)(j + 1) * 1024;
#pragma unroll
              for (int i = 0; i < 4; ++i) wn[i] = *(const f32x4*)(wp + P4_COL(i)); }
            float v[8];
#pragma unroll
            for (int r = 0; r < 8; ++r) P4_DOT(v[r], r);
            float n3; P4_BFLY(n3, v);
            if (lane < 8) LG[lane * 40 + j] = n3;
        }
        LDS_WAIT();
        int gs_l = 0; float gm_l = 0.f;
        if (lane < 8) { LAS float* lg = LG + lane * 40; gm_l = lg[0] + bg[0];
            for (int j = 1; j < 4; ++j) { const float v = lg[j] + bg[j]; if (v > gm_l) { gm_l = v; gs_l = j; } } }
        int gsr[8];
#pragma unroll
        for (int r = 0; r < 8; ++r) gsr[r] = __builtin_amdgcn_readlane(gs_l, r);
        float pa[8], pb[8], pc[8], n3r[8];
#pragma unroll
        for (int r = 0; r < 8; ++r) { pa[r] = 0.f; pb[r] = 0.f; pc[r] = 0.f; n3r[r] = 0.f; }
        const bool b0 = lane & 1, b1 = lane & 2, b2 = lane & 4;
        for (int g = 0; g < 4; ++g) {
#pragma unroll
            for (int j = 0; j < 8; ++j) {
                f32x4 wv[4];
#pragma unroll
                for (int i = 0; i < 4; ++i) wv[i] = wn[i];
                { const int nx_ = 5 + 8 * g + j; const float* wp = RWT + (size_t)(nx_ < 36 ? nx_ : 35) * 1024;
#pragma unroll
                  for (int i = 0; i < 4; ++i) wn[i] = *(const f32x4*)(wp + P4_COL(i)); }
#pragma unroll
                for (int r = 0; r < 8; ++r) if (gsr[r] == g) {
                    float d; P4_DOT(d, r);
                    if ((j & 1) == 0) pa[r] = d;
                    else { float n1 = (b0 ? d : pa[r]) + dpp_xor1(b0 ? pa[r] : d);
                        if ((j & 2) == 0) pb[r] = n1;
                        else { float n2 = (b1 ? n1 : pb[r]) + dpp_xor2(b1 ? pb[r] : n1);
                            if ((j & 4) == 0) pc[r] = n2;
                            else n3r[r] = (b2 ? n2 : pc[r]) + dpp_xor4(b2 ? pc[r] : n2, b2); } } }
            }
        }
#pragma unroll
        for (int r = 0; r < 8; ++r) { float n3 = n3r[r]; n3 += dpp_xor8(n3); n3 = xg_sum(n3); if (lane < 8) LG[r * 40 + 4 + gsr[r] * 8 + lane] = n3; }
#undef P4_DOT
#undef P4_BFLY
#undef P4_COL
        LDS_WAIT();
        {
            const int rr_ = lane >> 3, jj_ = lane & 7; const bool c2 = (lane & 4) != 0;
            LAS float* lg = LG + rr_ * 40;
            const float g0 = lg[0] + bg[0], g1 = lg[1] + bg[1], g2 = lg[2] + bg[2], g3 = lg[3] + bg[3];
            int gs = 0; float gm = g0; if (g1 > gm) { gm = g1; gs = 1; } if (g2 > gm) { gm = g2; gs = 2; } if (g3 > gm) { gm = g3; gs = 3; }
            const float pg = 1.f / (((expf(g0 - gm) + expf(g1 - gm)) + expf(g2 - gm)) + expf(g3 - gm));
            const float v = lg[4 + gs * 8 + jj_] + be[gs * 8 + jj_];
            float em = v; em = fmaxf(em, dpp_xor1(em)); em = fmaxf(em, dpp_xor2(em)); em = fmaxf(em, dpp_xor4(em, c2));
            const float ex = expf(v - em); float es = ex; es += dpp_xor1(es); es += dpp_xor2(es); es += dpp_xor4(es, c2);
            const float pj = ex / es;
#define P4_AMAX(pv, iv) do { float op_; int oi_; \
                op_ = dpp_xor1(pv); oi_ = __float_as_int(dpp_xor1(__int_as_float(iv))); if (op_ > pv || (op_ == pv && oi_ < iv)) { pv = op_; iv = oi_; } \
                op_ = dpp_xor2(pv); oi_ = __float_as_int(dpp_xor2(__int_as_float(iv))); if (op_ > pv || (op_ == pv && oi_ < iv)) { pv = op_; iv = oi_; } \
                op_ = dpp_xor4(pv, c2); oi_ = __float_as_int(dpp_xor4(__int_as_float(iv), c2)); if (op_ > pv || (op_ == pv && oi_ < iv)) { pv = op_; iv = oi_; } } while (0)
            float p0 = pj; int i0 = jj_; P4_AMAX(p0, i0);
            float p1 = (jj_ == i0) ? -1.f : pj; int i1 = jj_; P4_AMAX(p1, i1);
#undef P4_AMAX
            if (jj_ == 0) { const float sp = p0 + p1; const int rr = w * 8 + rr_;
                RT_E[rr * 2 + 0] = gs * 8 + i0; RT_E[rr * 2 + 1] = gs * 8 + i1; RT_G[rr * 2 + 0] = p0 / sp * pg; RT_G[rr * 2 + 1] = p1 / sp * pg; }
        }
        if (args.pad != 0) { __syncthreads(); continue; }
        if (tid < 32) LCNT[tid] = 0;
        __syncthreads();
        if (tid < 128) RT_P[tid] = atomicAdd((int*)&LCNT[RT_E[tid]], 1);
        __syncthreads();
        if (tid < 32) { int t_ = tid; asm volatile("" : "+v"(t_));
            const int c = LCNT[t_]; LBASE[t_] = c ? (int)__hip_atomic_fetch_add(gcount + t_, (unsigned)c, __ATOMIC_RELAXED, __HIP_MEMORY_SCOPE_AGENT) : 0; }
        __syncthreads();
        if (tid < 128) { const int e = RT_E[tid], pos = LBASE[e] + RT_P[tid], tok = blk * 64 + (tid >> 1);
            LIST[e * 16384 + pos] = tok; GLIST[e * 16384 + pos] = RT_G[tid]; TOK2[tok * 2 + (tid & 1)] = (e << 16) | pos; }
        __syncthreads();
    }
}

struct MoeSched1 {
    MoeTab t; int G, c; const char* A; const char* W; const int* LIST;
    __device__ bool next(int i, pg8::Unit& u) const {
        const int nt = __builtin_amdgcn_readfirstlane(t.nt[0]); const int idx = (P5_DUP_MOE1 == 2 ? (i > 0 ? i - 1 : 0) : (i >> P5_DUP_MOE1)) * G + c; if (idx >= 2 * nt) return false;
        const int mt = __builtin_amdgcn_readfirstlane(t.ord[idx >> 1]), pn = idx & 1; const int e = __builtin_amdgcn_readfirstlane(t.tile_e[mt]); const int m_in = mt - __builtin_amdgcn_readfirstlane(t.tpre[e]);
        const int left = __builtin_amdgcn_readfirstlane(t.cnt[e]) - 256 * m_in;
        u.a = A; u.b = W + ((size_t)e * 512 + 256 * pn) * 1024 * 2; u.row0 = 256 * mt; u.col0 = 128 * pn; u.aux = e * 16384 + 256 * m_in; u.rows = LIST + e * 16384 + 256 * m_in; u.nrows = left < 256 ? left : 256; return true;
    }
    __device__ __forceinline__ void ready(const pg8::Unit&) const {}
    __device__ __forceinline__ void ready_first(const pg8::Unit&) const {}
    __device__ __forceinline__ void done(const pg8::Unit&) const {}
};
struct EpiMoe1 {
    static constexpr bool PERM = true;
    bf16* H; const float* GLIST;
    __device__ __forceinline__ void operator()(const f32x4 (&acc)[2][2][4][2], const pg8::Unit& u, int wr, int wc, int fr, int fq) const {
        const int col = u.col0 + wc * 32 + 8 * fq;
#pragma unroll
        for (int ai = 0; ai < 2; ++ai)
#pragma unroll
            for (int m = 0; m < 4; ++m) { const int rl = ai * 128 + wr * 64 + m * 16 + fr; const float gt = (rl < u.nrows) ? GLIST[u.aux + rl] : 0.f;
                float h[8];
#pragma unroll
                for (int n = 0; n < 2; ++n)
#pragma unroll
                    for (int i = 0; i < 4; ++i) { const float a = acc[ai][0][m][n][i], b = acc[ai][1][m][n][i]; h[4 * n + i] = a * __builtin_amdgcn_rcpf(1.f + __builtin_amdgcn_exp2f(-1.4426950408889634f * a)) * b * gt; }
                v4u o; o.x = pg8::cvt_pk_bf16(h[0], h[1]); o.y = pg8::cvt_pk_bf16(h[2], h[3]); o.z = pg8::cvt_pk_bf16(h[4], h[5]); o.w = pg8::cvt_pk_bf16(h[6], h[7]);
                *(v4u*)(H + (size_t)(u.row0 + rl) * 256 + col) = o; }
    }
};
struct MoeSched2 {
    MoeTab t; int G, c; const char* Hb; const char* W;
    __device__ bool next(int i, pg8::Unit& u) const {
        const int nt = __builtin_amdgcn_readfirstlane(t.nt[0]); const int idx = i * G + c; if (idx >= 4 * nt) return false;
        const int mt = __builtin_amdgcn_readfirstlane(t.ord[idx >> 2]), pn = idx & 3; const int e = __builtin_amdgcn_readfirstlane(t.tile_e[mt]);
        const int left = __builtin_amdgcn_readfirstlane(t.cnt[e]) - 256 * (mt - __builtin_amdgcn_readfirstlane(t.tpre[e]));
        u.a = Hb + (size_t)mt * 256 * 256 * 2; u.b = W + ((size_t)e * 1024 + 256 * pn) * 256 * 2; u.row0 = 256 * mt; u.col0 = 256 * pn; u.aux = 0; u.rows = nullptr; u.nrows = left < 256 ? left : 256; return true;
    }
    __device__ __forceinline__ void ready(const pg8::Unit&) const {}
    __device__ __forceinline__ void ready_first(const pg8::Unit&) const {}
    __device__ __forceinline__ void done(const pg8::Unit&) const {}
};

struct PwSched {
    LAS int* tb; int G, c; const char* A; const char* Bt;
    __device__ bool next(int i, pg8::Unit& u) const {
        const int nt = __builtin_amdgcn_readfirstlane(tb[320]); int nheavy = 2 * nt - G; nheavy = nheavy < 0 ? 0 : (nheavy > G / 2 ? G / 2 : nheavy);
        if (c < nheavy) return false; const int idx = i * (G - nheavy) + (c - nheavy); if (idx >= (T / 256) * 4) return false;
        const int pm = idx >> 2, pn = idx & 3;
        u.a = A + (size_t)pm * 256 * 256 * 2; u.b = Bt + (size_t)pn * 256 * 256 * 2; u.row0 = pm * 256; u.col0 = pn * 256; u.aux = 0; u.rows = nullptr; u.nrows = 256; return true;
    }
    __device__ __forceinline__ void ready(const pg8::Unit&) const {}
    __device__ __forceinline__ void ready_first(const pg8::Unit&) const {}
    __device__ __forceinline__ void done(const pg8::Unit&) const {}
};

__device__ __forceinline__ void p7_ln2(Frame& F, const Args& args, int L, const bf16* X1b, const bf16* Y, bf16* X2b) {
    MoeTab t = moe_tab(F);
    const float* lng = args.in[16] + L * 1024; const float* lnb = args.in[17] + L * 1024; const int* TOK2 = (const int*)(F.ws + WS_TOK2);
    const int lane = ((int)threadIdx.x & 63);
    const int stride = F.G * NWAVES;
    for (int row0 = F.vcu * NWAVES + F.wave; row0 < T; row0 += 4 * stride) {
        int rows[4]; size_t s0[4], s1[4];
#pragma unroll
        for (int u = 0; u < 4; ++u) { rows[u] = row0 + u * stride < T ? row0 + u * stride : row0; const int k0 = TOK2[rows[u] * 2], k1 = TOK2[rows[u] * 2 + 1];
            s0[u] = (size_t)256 * t.tpre[k0 >> 16] + (k0 & 0xffff); s1[u] = (size_t)256 * t.tpre[k1 >> 16] + (k1 & 0xffff); }
        v4u xb[4][2], ya[4][2], yb[4][2];
#pragma unroll
        for (int u = 0; u < 4; ++u)
#pragma unroll
            for (int i = 0; i < 2; ++i) { const int c = 8 * lane + 512 * i; xb[u][i] = __builtin_nontemporal_load((const v4u*)(X1b + (size_t)rows[u] * 1024 + c)); ya[u][i] = __builtin_nontemporal_load((const v4u*)(Y + s0[u] * 1024 + c)); yb[u][i] = __builtin_nontemporal_load((const v4u*)(Y + s1[u] * 1024 + c)); }
#pragma unroll
        for (int u = 0; u < 4; ++u) {
            f32x4 v[4]; float s = 0.f;
#pragma unroll
            for (int i = 0; i < 2; ++i) { const v4u x = xb[u][i], a = ya[u][i], b = yb[u][i];
                v[2 * i][0] = ALPHA * bflo(x.x) + (bflo(a.x) + bflo(b.x)); v[2 * i][1] = ALPHA * bfhi(x.x) + (bfhi(a.x) + bfhi(b.x)); v[2 * i][2] = ALPHA * bflo(x.y) + (bflo(a.y) + bflo(b.y)); v[2 * i][3] = ALPHA * bfhi(x.y) + (bfhi(a.y) + bfhi(b.y));
                v[2 * i + 1][0] = ALPHA * bflo(x.z) + (bflo(a.z) + bflo(b.z)); v[2 * i + 1][1] = ALPHA * bfhi(x.z) + (bfhi(a.z) + bfhi(b.z)); v[2 * i + 1][2] = ALPHA * bflo(x.w) + (bflo(a.w) + bflo(b.w)); v[2 * i + 1][3] = ALPHA * bfhi(x.w) + (bfhi(a.w) + bfhi(b.w));
                s += ((v[2 * i][0] + v[2 * i][1]) + (v[2 * i][2] + v[2 * i][3])) + ((v[2 * i + 1][0] + v[2 * i + 1][1]) + (v[2 * i + 1][2] + v[2 * i + 1][3])); }
            const float mean = wave_sum_fast(s) * (1.f / 1024.f); float q = 0.f;
#pragma unroll
            for (int i = 0; i < 4; ++i) { v[i] = v[i] - mean; q += (v[i][0] * v[i][0] + v[i][1] * v[i][1]) + (v[i][2] * v[i][2] + v[i][3] * v[i][3]); }
            const float rstd = rsqrtf(wave_sum_fast(q) * (1.f / 1024.f) + 1e-5f);
            if (row0 + u * stride < T) {
#pragma unroll
                for (int i = 0; i < 2; ++i) { const int c = 8 * lane + 512 * i;
                    const f32x4 g0 = *(const f32x4*)(lng + c), g1 = *(const f32x4*)(lng + c + 4), b0 = *(const f32x4*)(lnb + c), b1 = *(const f32x4*)(lnb + c + 4);
                    const f32x4 o0 = v[2 * i] * rstd * g0 + b0, o1 = v[2 * i + 1] * rstd * g1 + b1;
                    v4u ob; ob.x = pk2(o0[0], o0[1]); ob.y = pk2(o0[2], o0[3]); ob.z = pk2(o1[0], o1[1]); ob.w = pk2(o1[2], o1[3]); *(v4u*)(X2b + (size_t)rows[u] * 1024 + c) = ob; } }
        }
    }
}


struct EpiPle {
    static constexpr bool PERM = true;
    const bf16* X2b; const bf16* PW; const float* gb; float* outf; bf16* outb;
    __device__ __forceinline__ void operator()(const f32x4 (&acc)[2][2][4][2], const pg8::Unit& u, int wr, int wc, int fr, int fq) const {
        const int col0 = u.col0 + wc * 32 + 8 * fq;
#pragma unroll
        for (int ai = 0; ai < 2; ++ai)
#pragma unroll
            for (int m = 0; m < 4; ++m) { const size_t rowoff = (size_t)(u.row0 + wr * 64 + fr + ai * 128 + m * 16) * 1024;
#pragma unroll
                for (int bj = 0; bj < 2; ++bj) { const int c = col0 + bj * 128;
                    const v4u pw = *(const v4u*)(PW + rowoff + c), xb = *(const v4u*)(X2b + rowoff + c);
                    const unsigned pwv[4] = {pw.x, pw.y, pw.z, pw.w}, xbv[4] = {xb.x, xb.y, xb.z, xb.w}; unsigned ob[4];
#pragma unroll
                    for (int n = 0; n < 2; ++n) { const f32x4 g0 = *(const f32x4*)(gb + c + 4 * n); const f32x4 z0 = acc[ai][bj][m][n] + g0; f32x4 o0;
                        o0[0] = bflo(xbv[2 * n]) + bflo(pwv[2 * n]) * __builtin_amdgcn_rcpf(1.f + __builtin_amdgcn_exp2f(-1.4426950408889634f * z0[0]));
                        o0[1] = bfhi(xbv[2 * n]) + bfhi(pwv[2 * n]) * __builtin_amdgcn_rcpf(1.f + __builtin_amdgcn_exp2f(-1.4426950408889634f * z0[1]));
                        o0[2] = bflo(xbv[2 * n + 1]) + bflo(pwv[2 * n + 1]) * __builtin_amdgcn_rcpf(1.f + __builtin_amdgcn_exp2f(-1.4426950408889634f * z0[2]));
                        o0[3] = bfhi(xbv[2 * n + 1]) + bfhi(pwv[2 * n + 1]) * __builtin_amdgcn_rcpf(1.f + __builtin_amdgcn_exp2f(-1.4426950408889634f * z0[3]));
                        if (outf) __builtin_nontemporal_store(o0, (f32x4*)(outf + rowoff + c + 4 * n));
                        ob[2 * n] = pg8::cvt_pk_bf16(o0[0], o0[1]); ob[2 * n + 1] = pg8::cvt_pk_bf16(o0[2], o0[3]); }
                    if (outb) { v4u w; w.x = ob[0]; w.y = ob[1]; w.z = ob[2]; w.w = ob[3]; *(v4u*)(outb + rowoff + c) = w; } }
                if (m == 3) asm volatile("" ::: "memory"); }
    }
};
__device__ __forceinline__ void p8_ple(Frame& F, const Args& args, int L, const bf16* X2b, bf16* PW, float* outf, bf16* outb) {
    unsigned char* ws = F.ws;
    { pg8::Gemm g{1024, 1024, 1024}; pg8::StaticOrder S; S.init(T, 1024, F.G, (int)blockIdx.x, X2b, ws + WS_WG + (size_t)L * 1024 * 1024 * 2, 1024, 1024);
      EpiPle E{X2b, PW, args.in[26] + L * 1024, outf, outb};
      pg8::gemm_phase<EpiPle, pg8::StaticOrder, false>(F.lds, g, S, E); }
}


struct WqlatSched {
    int G, c; const char* wuk; const char* wbq;
    __device__ bool next(int i, pg8::Unit& u) const { const int idx = i * G + c; if (idx >= 32) return false; const int h = idx >> 2, pn = idx & 3;
        u.a = wuk + (size_t)h * 256 * 128 * 2; u.b = wbq + ((size_t)pn * 256 * 1024 + h * 128) * 2; u.row0 = h * 256; u.col0 = pn * 256; u.aux = 0; u.rows = nullptr; u.nrows = 256; return true; }
    __device__ __forceinline__ void ready(const pg8::Unit&) const {}
    __device__ __forceinline__ void ready_first(const pg8::Unit&) const {}
    __device__ __forceinline__ void done(const pg8::Unit&) const {}
};
struct WcombSched {
    int G, c; const char* wbout; const char* wuv;
    __device__ bool next(int i, pg8::Unit& u) const { const int idx = i * G + c - 32; if (idx < 0 || idx >= 32) return false; const int pm = idx >> 3, h = idx & 7;
        u.a = wbout + ((size_t)pm * 256 * 1024 + h * 128) * 2; u.b = wuv + (size_t)h * 256 * 128 * 2; u.row0 = pm * 256; u.col0 = h * 256; u.aux = 0; u.rows = nullptr; u.nrows = 256; return true; }
    __device__ __forceinline__ void ready(const pg8::Unit&) const {}
    __device__ __forceinline__ void ready_first(const pg8::Unit&) const {}
    __device__ __forceinline__ void done(const pg8::Unit&) const {}
};

constexpr int PW_ = 3072;
__device__ __forceinline__ unsigned f2key_d(float f) { const int u = __float_as_int(f); return (unsigned)(u ^ ((u >> 31) | (int)0x80000000)); }
__device__ __forceinline__ int wave_sum_i(int v) {
    v += __builtin_amdgcn_update_dpp(0, v, 0x111, 0xf, 0xf, false);
    v += __builtin_amdgcn_update_dpp(0, v, 0x112, 0xf, 0xf, false);
    v += __builtin_amdgcn_update_dpp(0, v, 0x114, 0xf, 0xf, false);
    v += __builtin_amdgcn_update_dpp(0, v, 0x118, 0xf, 0xf, false);
    v += __builtin_amdgcn_update_dpp(0, v, 0x142, 0xa, 0xf, false);
    v += __builtin_amdgcn_update_dpp(0, v, 0x143, 0xc, 0xf, false);
    return __builtin_amdgcn_readlane(v, 63);
}
__device__ __forceinline__ int wave_scan_i(int v) {
    v += __builtin_amdgcn_update_dpp(0, v, 0x111, 0xf, 0xf, false);
    v += __builtin_amdgcn_update_dpp(0, v, 0x112, 0xf, 0xf, false);
    v += __builtin_amdgcn_update_dpp(0, v, 0x114, 0xf, 0xf, false);
    v += __builtin_amdgcn_update_dpp(0, v, 0x118, 0xf, 0xf, false);
    v += __builtin_amdgcn_update_dpp(0, v, 0x142, 0xa, 0xf, false);
    v += __builtin_amdgcn_update_dpp(0, v, 0x143, 0xc, 0xf, false);
    return v;
}
__device__ __forceinline__ unsigned umax_(unsigned a, unsigned b) { return a > b ? a : b; }
__device__ __forceinline__ unsigned umin_(unsigned a, unsigned b) { return a < b ? a : b; }
__device__ __forceinline__ unsigned wave_max_u(unsigned v) {
    v = umax_(v, (unsigned)__builtin_amdgcn_update_dpp(0, (int)v, 0x111, 0xf, 0xf, false)); v = umax_(v, (unsigned)__builtin_amdgcn_update_dpp(0, (int)v, 0x112, 0xf, 0xf, false));
    v = umax_(v, (unsigned)__builtin_amdgcn_update_dpp(0, (int)v, 0x114, 0xf, 0xf, false)); v = umax_(v, (unsigned)__builtin_amdgcn_update_dpp(0, (int)v, 0x118, 0xf, 0xf, false));
    v = umax_(v, (unsigned)__builtin_amdgcn_update_dpp(0, (int)v, 0x142, 0xa, 0xf, false)); v = umax_(v, (unsigned)__builtin_amdgcn_update_dpp(0, (int)v, 0x143, 0xc, 0xf, false));
    return (unsigned)__builtin_amdgcn_readlane((int)v, 63);
}
__device__ __forceinline__ unsigned wave_min_u(unsigned v) {
    v = umin_(v, (unsigned)__builtin_amdgcn_update_dpp(-1, (int)v, 0x111, 0xf, 0xf, false)); v = umin_(v, (unsigned)__builtin_amdgcn_update_dpp(-1, (int)v, 0x112, 0xf, 0xf, false));
    v = umin_(v, (unsigned)__builtin_amdgcn_update_dpp(-1, (int)v, 0x114, 0xf, 0xf, false)); v = umin_(v, (unsigned)__builtin_amdgcn_update_dpp(-1, (int)v, 0x118, 0xf, 0xf, false));
    v = umin_(v, (unsigned)__builtin_amdgcn_update_dpp(-1, (int)v, 0x142, 0xa, 0xf, false)); v = umin_(v, (unsigned)__builtin_amdgcn_update_dpp(-1, (int)v, 0x143, 0xc, 0xf, false));
    return (unsigned)__builtin_amdgcn_readlane((int)v, 63);
}
#define CNT4(c0, c1, c2, c3, k0, k1, k2, k3, thr) do { unsigned long long m0_, m1_, m2_, m3_; \
    asm volatile("v_cmp_ge_u32 %4, %8, %12\n\tv_cmp_ge_u32 %5, %9, %12\n\tv_cmp_ge_u32 %6, %10, %12\n\tv_cmp_ge_u32 %7, %11, %12\n\t" \
                 "v_addc_co_u32 %0, %4, 0, %0, %4\n\tv_addc_co_u32 %1, %5, 0, %1, %5\n\tv_addc_co_u32 %2, %6, 0, %2, %6\n\tv_addc_co_u32 %3, %7, 0, %3, %7" \
                 : "+v"(c0), "+v"(c1), "+v"(c2), "+v"(c3), "=&s"(m0_), "=&s"(m1_), "=&s"(m2_), "=&s"(m3_) : "v"(k0), "v"(k1), "v"(k2), "v"(k3), "v"(thr)); } while (0)
template <int NR> __device__ __forceinline__ int count_ge(const unsigned (&k)[NR], unsigned thr) {
    int c0 = 0, c1 = 0, c2 = 0, c3 = 0;
#pragma unroll
    for (int r = 0; r < NR; r += 4) CNT4(c0, c1, c2, c3, k[r], k[r + 1], k[r + 2], k[r + 3], thr);
    return wave_sum_i((c0 + c1) + (c2 + c3));
}
constexpr int CAPL = 12;
__device__ __forceinline__ int count_geC(const unsigned (&c)[CAPL], unsigned thr) {
    int c0 = 0, c1 = 0, c2 = 0, c3 = 0;
#pragma unroll
    for (int r = 0; r < CAPL; r += 4) CNT4(c0, c1, c2, c3, c[r], c[r + 1], c[r + 2], c[r + 3], thr);
    return wave_sum_i((c0 + c1) + (c2 + c3));
}
template <int NR> __device__ __forceinline__ void select_query(LAS unsigned* KEYS, LAS unsigned* HIST, LAS unsigned short* SEL, unsigned short* idx_out, int lane, int w, int tq, int nk32) {
              unsigned k[NR];
#pragma unroll
              for (int r = 0; r < NR; ++r) { const int idx = 64 * r + lane; k[r] = (r < NR - 8 || idx < nk32) ? KEYS[w * 4096 + idx] : 0u; }
              unsigned kmax = 0u, kmin1 = 0xffffffffu;
#pragma unroll
              for (int r = 0; r < NR; r += 2) { kmax = umax_(kmax, umax_(k[r], k[r + 1])); kmin1 = umin_(kmin1, umin_(k[r] - 1u, k[r + 1] - 1u)); }
              kmax = wave_max_u(kmax); const unsigned kmin = wave_min_u(kmin1) + 1u;
              unsigned lo = kmin, hi = kmax + 1u; int clo = tq + 1, chi = 0; bool exact = false;
              int iter = 0;
              for (;; ++iter) { const unsigned span = hi - lo; if (span <= 1u || clo - chi <= 256) break;
                  unsigned off = span >> 1;
                  if (!(iter & 1)) { const float fr = (float)(clo - 256) * __builtin_amdgcn_rcpf((float)(clo - chi)); off = (unsigned)((float)span * fr); off = off < 1u ? 1u : (off > span - 1u ? span - 1u : off); }
                  const unsigned mid = lo + off;
                  const int c = count_ge<NR>(k, mid);
                  if (c == 256) { lo = mid; exact = true; break; }
                  if (c > 256) { lo = mid; clo = c; } else { hi = mid; chi = c; } }
              if (!exact && hi - lo > 1u) {
                  unsigned slot = lane;
#pragma unroll
                  for (int r = 0; r < NR; ++r) { const bool in = (k[r] - lo) < (hi - lo); const unsigned sl = in ? umin_(slot, 64u * CAPL + lane) : (64u * CAPL + lane); HIST[sl] = k[r]; slot += in ? 64u : 0u; }
                  const int cntl = (int)((slot - lane) >> 6);
                  const bool full = __builtin_amdgcn_ballot_w64(cntl > CAPL) != 0ull;
                  LDS_WAIT();
                  unsigned c8[CAPL];
#pragma unroll
                  for (int r = 0; r < CAPL; ++r) c8[r] = (r < cntl) ? HIST[lane + 64 * r] : 0u;
                  const int chi0 = chi;
                  for (;; ++iter) { const unsigned span = hi - lo; if (span <= 1u) break;
                      unsigned off = span >> 1;
                      if (!(iter & 1)) { const float fr = (float)(clo - 256) * __builtin_amdgcn_rcpf((float)(clo - chi)); off = (unsigned)((float)span * fr); off = off < 1u ? 1u : (off > span - 1u ? span - 1u : off); }
                      const unsigned mid = lo + off;
                      const int c = full ? count_ge<NR>(k, mid) : chi0 + count_geC(c8, mid);
                      if (c == 256) { lo = mid; exact = true; break; }
                      if (c > 256) { lo = mid; clo = c; } else { hi = mid; chi = c; } }
              }
              const unsigned thr = exact ? lo : hi; const int need = exact ? 0 : 256 - chi;
              { int cl = 0; { int e0 = 0, e1 = 0, e2 = 0, e3 = 0;
#pragma unroll
                for (int r = 0; r < NR; r += 4) CNT4(e0, e1, e2, e3, k[r], k[r + 1], k[r + 2], k[r + 3], thr);
                cl = (e0 + e1) + (e2 + e3); }
                const int inc = wave_scan_i(cl);
                int off = inc - cl;
#pragma unroll
                for (int r = 0; r < NR; ++r) { const bool pr = k[r] >= thr; SEL[pr ? off : 256 + lane] = (unsigned short)(64 * r + lane); off += pr ? 1 : 0; } }
              if (need > 0) { const unsigned long long ltmask = (1ull << lane) - 1ull; const int base = 256 - need; int tb = 0;
#pragma unroll
                  for (int r = 0; r < NR; ++r) { const bool pr = k[r] == lo; const unsigned long long m = __builtin_amdgcn_ballot_w64(pr); const int rk = tb + __popcll(m & ltmask);
                      if (pr && rk < need) SEL[base + rk] = (unsigned short)(64 * r + lane); tb += __popcll(m); } }
              LDS_WAIT();
              *(v2u*)(idx_out + 4 * lane) = *(const LAS v2u*)(SEL + 4 * lane);
}

__device__ __forceinline__ void p10_index(Frame& F, const Args& args, const XcdBarrier& bar, bool do_norm) {
    unsigned char* ws = F.ws; bf16* PROJ = (bf16*)(ws + WS_D); unsigned short* IDX = (unsigned short*)(ws + WS_G); const float* kvg = args.in[10];
    unsigned char* KF = ws + WS_KF;
    const int lane = ((int)threadIdx.x & 63), w = F.wave;
    if (do_norm) {
        for (int row0 = F.vcu * NWAVES + w; row0 < T; row0 += 8 * F.G * NWAVES) {
            v2u a[8];
#pragma unroll
            for (int u = 0; u < 8; ++u) { const int row = row0 + u * F.G * NWAVES; a[u] = *(const v2u*)(PROJ + (size_t)(row < T ? row : row0) * PW_ + 2048 + 4 * lane); }
            const f32x4 g = *(const f32x4*)(kvg + 4 * lane);
#pragma unroll
            for (int u = 0; u < 8; ++u) { const int row = row0 + u * F.G * NWAVES;
                const float x0 = bflo(a[u].x), x1 = bfhi(a[u].x), x2 = bflo(a[u].y), x3 = bfhi(a[u].y); const float ss = wave_sum_fast((x0 * x0 + x1 * x1) + (x2 * x2 + x3 * x3));
                const float rs = rsqrtf(ss * (1.f / 256.f) + 1e-6f);
                v2u o; o.x = pk2(x0 * rs * g[0], x1 * rs * g[1]); o.y = pk2(x2 * rs * g[2], x3 * rs * g[3]);
                if (row < T) *(v2u*)(PROJ + (size_t)row * PW_ + 2048 + 4 * lane) = o; } }
    }
    LAS unsigned* KEYS = (LAS unsigned*)F.lds;
    LAS unsigned* HIST = (LAS unsigned*)(F.lds + XTRA_OFF + w * 3328);
    LAS unsigned short* SEL = (LAS unsigned short*)(F.lds + XTRA_OFF + 26624) + w * 320;
    const int r32 = lane & 31, hh = lane >> 5;
    const int qa = (r32 >> 4) & 1, qb = (r32 >> 3) & 1, qc = (r32 >> 2) & 1, qd = r32 & 3;
    for (int gq = 0;; ++gq) {
        const int pr_ = __builtin_amdgcn_readfirstlane(F.vcu + F.G * (gq >> 1)); if (pr_ >= T / 16) break;
        const int b = pr_ >> 8, cc_ = pr_ & 255; const int t0 = ((gq & 1) ? 511 - cc_ : cc_) * 8;
        if (t0 + 8 <= 256) continue;
        const int nk = t0 + 8, ntile = (nk + 31) >> 5, nk32 = ntile * 32;
        const size_t brow = (size_t)b * SEQ;
        for (int rs_ = 0; rs_ < 1 + P10_DUP_SCORE; ++rs_) {
          const unsigned char* kfb = KF + (size_t)b * 128 * 4096 + (hh * 32 + r32) * 16;
#define P10_LOADB(dst, kt0_) do { _Pragma("unroll") for (int u = 0; u < 2; ++u) { const int kt_ = (kt0_) + 8 * u; const unsigned char* kp_ = kfb + (size_t)(kt_ < ntile ? kt_ : 0) * 4096; \
              _Pragma("unroll") for (int ks = 0; ks < 4; ++ks) dst[u][ks] = *(const bf16x8*)(kp_ + ks * 1024); } } while (0)
#define P10_COMP(src, kt0_) do { _Pragma("unroll") for (int u = 0; u < 2; ++u) { const int kt = (kt0_) + 8 * u; \
              if (kt < ntile) { const int key = kt * 32 + r32; \
                  _Pragma("unroll") for (int mi = 0; mi < 2; ++mi) { f32x16 acc; \
                      _Pragma("unroll") for (int i = 0; i < 16; ++i) acc[i] = 0.f; \
                      _Pragma("unroll") for (int ks = 0; ks < 4; ++ks) acc = __builtin_amdgcn_mfma_f32_32x32x16_bf16(Af[mi][ks], src[u][ks], acc, 0, 0, 0); \
                      _Pragma("unroll") for (int a = 0; a < 2; ++a) { float sc = 0.f; \
                          _Pragma("unroll") for (int bb = 0; bb < 2; ++bb) _Pragma("unroll") for (int d = 0; d < 4; ++d) { const int b_ = __float_as_int(acc[4 * (2 * a + bb) + d]); const float m_ = __int_as_float(b_ > 0 ? b_ : 0);     asm("v_fmac_f32 %0, %1, %2" : "+v"(sc) : "v"(m_), "v"(wq[mi][a][4 * bb + d])); }     \
                          const int ql = 4 * mi + 2 * hh + a; const int tq = t0 + ql; \
                          KEYS[ql * 4096 + key] = (key <= tq) ? f2key_d(sc) : 0u; } } } } } while (0)
          bf16x8 B0[2][4], B1[2][4];
          P10_LOADB(B0, w);
          bf16x8 Af[2][4]; float wq[2][2][8];
#pragma unroll
          for (int mi = 0; mi < 2; ++mi) { const bf16* qp = PROJ + (brow + t0 + 4 * mi + 2 * qc + qa) * PW_ + 2304 + (4 * qb + qd) * 64 + 8 * hh;
#pragma unroll
              for (int ks = 0; ks < 4; ++ks) Af[mi][ks] = *(const bf16x8*)(qp + 16 * ks);
#pragma unroll
              for (int a = 0; a < 2; ++a) { const v4u wv = *(const v4u*)(PROJ + (brow + t0 + 4 * mi + 2 * hh + a) * PW_ + 2880);
                  wq[mi][a][0] = bflo(wv.x); wq[mi][a][1] = bfhi(wv.x); wq[mi][a][2] = bflo(wv.y); wq[mi][a][3] = bfhi(wv.y); wq[mi][a][4] = bflo(wv.z); wq[mi][a][5] = bfhi(wv.z); wq[mi][a][6] = bflo(wv.w); wq[mi][a][7] = bfhi(wv.w);
#pragma unroll
                  for (int h = 0; h < 8; ++h) wq[mi][a][h] *= 0.04419417382415922f; } }
          {
            for (int kt0 = w; kt0 < ntile; kt0 += 32) {
                if (kt0 + 16 < ntile) P10_LOADB(B1, kt0 + 16);
                P10_COMP(B0, kt0);
                if (kt0 + 16 < ntile) { if (kt0 + 32 < ntile) P10_LOADB(B0, kt0 + 32); P10_COMP(B1, kt0 + 16); }
            } }
#undef P10_LOADB
#undef P10_COMP
          }
        __syncthreads();
        { const int tq = t0 + w;
          if (tq >= 256) { unsigned short* io = IDX + (brow + tq) * 256;
              if (nk32 <= 512) select_query<8>(KEYS, HIST, SEL, io, lane, w, tq, nk32);
              else if (nk32 <= 1024) select_query<16>(KEYS, HIST, SEL, io, lane, w, tq, nk32);
              else if (nk32 <= 1536) select_query<24>(KEYS, HIST, SEL, io, lane, w, tq, nk32);
              else if (nk32 <= 2048) select_query<32>(KEYS, HIST, SEL, io, lane, w, tq, nk32);
              else if (nk32 <= 2560) select_query<40>(KEYS, HIST, SEL, io, lane, w, tq, nk32);
              else if (nk32 <= 3072) select_query<48>(KEYS, HIST, SEL, io, lane, w, tq, nk32);
              else if (nk32 <= 3584) select_query<56>(KEYS, HIST, SEL, io, lane, w, tq, nk32);
              else select_query<64>(KEYS, HIST, SEL, io, lane, w, tq, nk32);
#if P10_DUP_SEL
              asm volatile("" ::: "memory");
              if (nk32 <= 512) select_query<8>(KEYS, HIST, SEL, io, lane, w, tq, nk32);
              else if (nk32 <= 1024) select_query<16>(KEYS, HIST, SEL, io, lane, w, tq, nk32);
              else if (nk32 <= 1536) select_query<24>(KEYS, HIST, SEL, io, lane, w, tq, nk32);
              else if (nk32 <= 2048) select_query<32>(KEYS, HIST, SEL, io, lane, w, tq, nk32);
              else if (nk32 <= 2560) select_query<40>(KEYS, HIST, SEL, io, lane, w, tq, nk32);
              else if (nk32 <= 3072) select_query<48>(KEYS, HIST, SEL, io, lane, w, tq, nk32);
              else if (nk32 <= 3584) select_query<56>(KEYS, HIST, SEL, io, lane, w, tq, nk32);
              else select_query<64>(KEYS, HIST, SEL, io, lane, w, tq, nk32);
#endif
          } }
        __syncthreads();
    }
}

__device__ __forceinline__ void p11_attn(Frame& F) {
    unsigned char* ws = F.ws; const bf16* PROJ = (const bf16*)(ws + WS_D); const unsigned short* IDX = (const unsigned short*)(ws + WS_G); bf16* OLAT = (bf16*)(ws + WS_B);
    const int lane = ((int)threadIdx.x & 63), w = F.wave, lr = lane & 15, g = lane >> 4, hf = lane >> 5, c32 = lane & 31;
    LAS unsigned char* IMG = F.lds + w * 16384;
    LAS unsigned* KLB = (LAS unsigned*)(F.lds + XTRA_OFF) + w * 512;
    const unsigned rho0 = 8 * (lr >> 2) + (lr & 3);
    const unsigned wimg = (c32 >> 4) * 8192;
#if P11_STAGGER
    for (int d_ = 0; d_ < P11_STAGGER * w; ++d_) __builtin_amdgcn_s_sleep(8);
#endif
#define P11_KEYS(dst, q_) do { const int t_ = (q_) & 4095; const int cnt_ = t_ + 1 < 256 ? t_ + 1 : 256; const int p0_ = 4 * lane; \
        if (t_ >= 256) dst = *(const v2u*)(IDX + (size_t)(q_) * 256 + p0_); \
        else { const unsigned a0 = p0_ < cnt_ ? p0_ : 0, a1 = p0_ + 1 < cnt_ ? p0_ + 1 : 0, a2 = p0_ + 2 < cnt_ ? p0_ + 2 : 0, a3 = p0_ + 3 < cnt_ ? p0_ + 3 : 0; dst.x = a0 | (a1 << 16); dst.y = a2 | (a3 << 16); } } while (0)
    const int q0 = F.vcu * NWAVES + w, qstep = F.G * NWAVES;
#define P11_PUT(buf_, kk_) (*(LAS v4u*)((buf_) + 4 * lane) = (v4u){((kk_).x & 0xffffu) * (unsigned)(PW_ * 2), ((kk_).x >> 16) * (unsigned)(PW_ * 2), ((kk_).y & 0xffffu) * (unsigned)(PW_ * 2), ((kk_).y >> 16) * (unsigned)(PW_ * 2)})
    if (q0 < T) { v2u kk; P11_KEYS(kk, q0); P11_PUT(KLB, kk); }
    int par = 0;
    for (int q = q0; q < T; q += qstep, par ^= 1) {
        const int b = q >> 12, t = q & 4095; const size_t brow = (size_t)b * SEQ; const size_t row = (size_t)q;
        const int cnt = t + 1 < 256 ? t + 1 : 256;
        LAS unsigned* KL = KLB + par * 256;
        v2u kkn = {0u, 0u}; const bool hasn = q + qstep < T;
        if (hasn) P11_KEYS(kkn, q + qstep);
        bf16x8 Qf[8];
#pragma unroll
        for (int ks = 0; ks < 8; ++ks) { bf16x8 v = *(const bf16x8*)(PROJ + row * PW_ + (lr & 7) * 256 + 32 * ks + 8 * g); if (lr >= 8) v = (bf16x8){0, 0, 0, 0, 0, 0, 0, 0}; Qf[ks] = v; }
        f32x4 O[16];
#pragma unroll
        for (int n = 0; n < 16; ++n) O[n] = (f32x4){0.f, 0.f, 0.f, 0.f};
        float m_run = -INFINITY, l_run = 0.f;
        const char* ckb = (const char*)(PROJ + brow * PW_ + 2048); const unsigned coff = 16u * c32;
        bf16x8 Cr[16];
        LDS_WAIT();
#define P11_LOAD(ch_) do { _Pragma("unroll") for (int j4_ = 0; j4_ < 4; ++j4_) { const v4u ko_ = *(const LAS v4u*)(KL + (ch_) * 32 + 16 * hf + 4 * j4_); \
                Cr[4 * j4_ + 0] = *(const bf16x8*)(ckb + (ko_.x + coff)); Cr[4 * j4_ + 1] = *(const bf16x8*)(ckb + (ko_.y + coff)); \
                Cr[4 * j4_ + 2] = *(const bf16x8*)(ckb + (ko_.z + coff)); Cr[4 * j4_ + 3] = *(const bf16x8*)(ckb + (ko_.w + coff)); } } while (0)
        P11_LOAD(0);
#pragma unroll
        for (int ch = 0; ch < 8; ++ch) {
            const int kbase = ch * 32;
            if (kbase < cnt) {
                for (int rw_ = 0; rw_ < 1 + P11_DUP_WR; ++rw_) {
#pragma unroll
                for (int j = 0; j < 16; ++j) *(LAS bf16x8*)(IMG + wimg + off_b(8 * (j >> 2) + (j & 3) + 4 * hf, c32 & 15)) = Cr[j];
                LDS_WAIT(); }
                if (ch < 7) { if (kbase + 32 < cnt) { for (int rl2_ = 0; rl2_ < 1 + P11_DUP_LD; ++rl2_) { P11_LOAD(ch + 1); asm volatile("" ::: "memory"); } } }
                f32x4 S[2];
                for (int rq_ = 0; rq_ < 1 + P11_DUP_QK; ++rq_)
#pragma unroll
                for (int rb = 0; rb < 2; ++rb) { f32x4 Se = (f32x4){0.f, 0.f, 0.f, 0.f}, So = (f32x4){0.f, 0.f, 0.f, 0.f};
#pragma unroll
                    for (int ks = 0; ks < 8; ++ks) { const unsigned cidx = 4 * ks + g; const bf16x8 Af = *(const LAS bf16x8*)(IMG + (cidx >> 4) * 8192 + off_b(rho0 + 4 * rb, cidx & 15));
                        if (ks & 1) So = __builtin_amdgcn_mfma_f32_16x16x32_bf16(Af, Qf[ks], So, 0, 0, 0); else Se = __builtin_amdgcn_mfma_f32_16x16x32_bf16(Af, Qf[ks], Se, 0, 0, 0); }
                    S[rb] = Se + So; }
                float cm = -INFINITY;
                if (kbase + 32 > cnt) {
                    asm volatile("" ::: "memory");
#pragma unroll
                    for (int rb = 0; rb < 2; ++rb)
#pragma unroll
                        for (int i = 0; i < 4; ++i) { const int kk = kbase + 16 * rb + 4 * g + i; if (kk >= cnt) S[rb][i] = -INFINITY; } }
#pragma unroll
                for (int rb = 0; rb < 2; ++rb)
#pragma unroll
                    for (int i = 0; i < 4; ++i) cm = fmaxf(cm, S[rb][i]);
                cm = xg_max(cm);
                const float m_new = fmaxf(m_run, cm); const float alpha = __builtin_amdgcn_exp2f(m_run - m_new); float rs = 0.f; float p[2][4];
#pragma unroll
                for (int rb = 0; rb < 2; ++rb)
#pragma unroll
                    for (int i = 0; i < 4; ++i) { p[rb][i] = __builtin_amdgcn_exp2f(S[rb][i] - m_new); rs += p[rb][i]; }
                rs = xg_sum(rs);
                l_run = l_run * alpha + rs; m_run = m_new;
                if (__builtin_amdgcn_ballot_w64(alpha != 1.0f) != 0ull) {
#pragma unroll
                    for (int n = 0; n < 16; ++n) O[n] = O[n] * alpha;
                }
                bf16x8 Pf; { const unsigned a0 = pk2(p[0][0], p[0][1]), a1 = pk2(p[0][2], p[0][3]), a2 = pk2(p[1][0], p[1][1]), a3 = pk2(p[1][2], p[1][3]);
                    Pf = (bf16x8){(short)(a0 & 0xffff), (short)(a0 >> 16), (short)(a1 & 0xffff), (short)(a1 >> 16), (short)(a2 & 0xffff), (short)(a2 >> 16), (short)(a3 & 0xffff), (short)(a3 >> 16)}; }
                bf16x8 Ba[2], Bb[2];
#define P11_TR(dst, n0) do { _Pragma("unroll") for (int j_ = 0; j_ < 2; ++j_) { const int n_ = (n0) + j_; LAS unsigned char* ib_ = IMG + (n_ >> 3) * 8192; \
                    const bf16x4 lo_ = tr_read(ib_ + tr_read_addr_16(lane, n_ & 7, 0, 0)), hi_ = tr_read(ib_ + tr_read_addr_16(lane, n_ & 7, 0, 1)); \
                    dst[j_] = (bf16x8){lo_[0], lo_[1], lo_[2], lo_[3], hi_[0], hi_[1], hi_[2], hi_[3]}; } } while (0)
#define P11_MM(src, n0) do { _Pragma("unroll") for (int j_ = 0; j_ < 2; ++j_) O[(n0) + j_] = __builtin_amdgcn_mfma_f32_16x16x32_bf16(src[j_], Pf, O[(n0) + j_], 0, 0, 0); } while (0)
                P11_TR(Ba, 0); P11_TR(Bb, 2); P11_MM(Ba, 0); P11_TR(Ba, 4); P11_MM(Bb, 2); P11_TR(Bb, 6); P11_MM(Ba, 4); P11_TR(Ba, 8); P11_MM(Bb, 6); P11_TR(Bb, 10); P11_MM(Ba, 8); P11_TR(Ba, 12); P11_MM(Bb, 10); P11_TR(Bb, 14); P11_MM(Ba, 12); P11_MM(Bb, 14);
#undef P11_TR
#undef P11_MM
                LDS_WAIT();
                if (ch == 0) { if (hasn) P11_PUT(KLB + (par ^ 1) * 256, kkn); }
            }
        }
#undef P11_LOAD
        const float linv = 1.f / l_run;
#pragma unroll
        for (int np = 0; np < 8; ++np) { unsigned x0 = pk2(O[2 * np][0] * linv, O[2 * np][1] * linv), x1 = pk2(O[2 * np][2] * linv, O[2 * np][3] * linv);
            unsigned y0 = pk2(O[2 * np + 1][0] * linv, O[2 * np + 1][1] * linv), y1 = pk2(O[2 * np + 1][2] * linv, O[2 * np + 1][3] * linv);
            const auto s0 = __builtin_amdgcn_permlane16_swap(x0, y0, false, false); const auto s1 = __builtin_amdgcn_permlane16_swap(x1, y1, false, false);
            v4u o; o.x = s0[0]; o.y = s1[0]; o.z = s0[1]; o.w = s1[1];
            if (lr < 8) *(v4u*)(OLAT + row * 2048 + lr * 256 + 32 * np + 16 * (g & 1) + 4 * (g & 2)) = o; }
    }
}
#undef P11_KEYS
#undef P11_PUT

__device__ __forceinline__ void tail_phases(Frame& F, const Args& args, const XcdBarrier& bar, int lo, int hi, int base, int L, const bf16* R, float* outf, bf16* outb) {
    unsigned char* ws = F.ws;
#define INB(k) (lo <= base + (k) && base + (k) < hi)
#define REPSB(k) (INB(k) ? 1 + ((DUP_MASK >> (base + (k))) & 1) : 0)
#define SEAMB(k) do { if (INB(k) && INB((k) + 1)) { xcd_barrier(bar); if (BAR_DUP) xcd_barrier(bar); } } while (0)
    for (int rep_ = 0; rep_ < REPSB(0); ++rep_) { p4_ln_router(F, args, L, R, (bf16*)(ws + WS_A)); }
    SEAMB(0);
    for (int rep_ = 0; rep_ < REPSB(1); ++rep_) {
        moe_tab_build(F, L);
        pg8::Gemm g{1024, 1024, 1024}; MoeSched1 S{moe_tab(F), F.G, F.vcu, (const char*)(ws + WS_A), (const char*)(ws + WS_WE_IN) + (size_t)L * 32 * 512 * 1024 * 2, (const int*)(ws + WS_LIST)};
        EpiMoe1 E{(bf16*)(ws + WS_D), (const float*)(ws + WS_GLIST)};
        pg8::gemm_phase<EpiMoe1, MoeSched1, true, !P5_NORAG>(F.lds, g, S, E);
        for (int rpw_ = 0; rpw_ < 1 + P5_DUP_PW; ++rpw_) { pg8::Gemm g2{256, 256, 256}; PwSched S2{(LAS int*)(F.lds + XTRA_OFF), F.G, F.vcu, (const char*)(ws + WS_PB) + (size_t)L * T * 256 * 2, (const char*)(ws + WS_WP) + (size_t)L * 1024 * 256 * 2};
          pg8::EpiBf16<0> E2{(bf16*)(ws + WS_B), 1024, nullptr, 1.f};
          pg8::gemm_phase<pg8::EpiBf16<0>, PwSched, false>(F.lds, g2, S2, E2); }
        if (L == 0 && rep_ == 0) {
            const int nt_ = moe_tab(F).nt[0]; int nheavy = 2 * nt_ - F.G; nheavy = nheavy < 0 ? 0 : (nheavy > F.G / 2 ? F.G / 2 : nheavy);
            __syncthreads();
            if (F.vcu >= nheavy) cvt_late(F, args, (F.vcu - nheavy) * NWAVES + F.wave, (F.G - nheavy) * NWAVES);
        }
    }
    SEAMB(1);
    for (int rep_ = 0; rep_ < REPSB(2); ++rep_) {
        moe_tab_build(F, L);
        pg8::Gemm g{256, 256, 256}; MoeSched2 S{moe_tab(F), F.G, F.vcu, (const char*)(ws + WS_D), (const char*)(ws + WS_WE_OUT) + (size_t)L * 32 * 1024 * 256 * 2};
        pg8::EpiBf16<0> E{(bf16*)(ws + WS_E), 1024, nullptr, 1.f};
        pg8::gemm_phase<pg8::EpiBf16<0>, MoeSched2, false, true>(F.lds, g, S, E);
        if (L == 0 && rep_ == 0) {
            { pg8::Gemm g{128, 128, 1024}; WqlatSched S{F.G, F.G - 1 - F.vcu, (const char*)(ws + WS_WUK), (const char*)(ws + WS_WBQ)}; pg8::EpiBf16<0> E{(bf16*)(ws + WS_WB_IN), 1024, nullptr, 0.08838834764831845f * 1.4426950408889634f};
              pg8::gemm_phase<pg8::EpiBf16<0>, WqlatSched, false>(F.lds, g, S, E); }
            { pg8::Gemm g{128, 1024, 128}; WcombSched S{F.G, F.G - 1 - F.vcu, (const char*)(ws + WS_WBOUT), (const char*)(ws + WS_WUV)}; pg8::EpiBf16<0> E{(bf16*)(ws + WS_WB_COMB), 2048, nullptr, 1.f};
              pg8::gemm_phase<pg8::EpiBf16<0>, WcombSched, false>(F.lds, g, S, E); }
        }
    }
    SEAMB(2);
    for (int rep_ = 0; rep_ < REPSB(3); ++rep_) { moe_tab_build(F, L); p7_ln2(F, args, L, (const bf16*)(ws + WS_A), (const bf16*)(ws + WS_E), (bf16*)(ws + WS_G)); }
    SEAMB(3);
    for (int rep_ = 0; rep_ < REPSB(4); ++rep_) { p8_ple(F, args, L, (const bf16*)(ws + WS_G), (bf16*)(ws + WS_B), outf, outb); }
#undef INB
#undef REPSB
#undef SEAMB
}
struct EpiProj {
    static constexpr bool PERM = true;
    bf16* O; unsigned char* KF;
    __device__ __forceinline__ void operator()(const f32x4 (&acc)[2][2][4][2], const pg8::Unit& u, int wr, int wc, int fr, int fq) const {
        const int row0 = u.row0 + wr * 64 + fr; const int col0 = u.col0 + wc * 32 + 8 * fq; const bool kt = (u.col0 == 2816) && (wc < 2);
#pragma unroll
        for (int ai = 0; ai < 2; ++ai)
#pragma unroll
            for (int m = 0; m < 4; ++m) { const int row = row0 + ai * 128 + m * 16; bf16* rowp = O + (size_t)row * 3072 + col0;
#pragma unroll
                for (int bj = 0; bj < 2; ++bj) { const f32x4 v0 = acc[ai][bj][m][0] + 0.f, v1 = acc[ai][bj][m][1] + 0.f;
                    v4u w; w.x = pg8::cvt_pk_bf16(v0[0], v0[1]); w.y = pg8::cvt_pk_bf16(v0[2], v0[3]); w.z = pg8::cvt_pk_bf16(v1[0], v1[1]); w.w = pg8::cvt_pk_bf16(v1[2], v1[3]);
                    *(v4u*)(rowp + bj * 128) = w;
                    if (bj == 0 && kt) *(v4u*)(KF + (size_t)(row >> 5) * 4096 + ((4 * wc + fq) * 32 + (row & 31)) * 16) = w; } }
    }
};
__global__ void __launch_bounds__(NWAVES * 64, 2) mega(Args args) {
    extern __shared__ __attribute__((aligned(16))) unsigned char lds_raw[];
    Frame F;
    F.lds = (LAS unsigned char*)lds_raw;
    F.wave = __builtin_amdgcn_readfirstlane((int)threadIdx.x >> 6);
    F.G = gridDim.x; { const int bx = blockIdx.x; F.vcu = (F.G % 8 == 0) ? (bx % 8) * (F.G / 8) + bx / 8 : bx; }
    F.ws = args.ws;
    unsigned char* ws = args.ws;
    const int lo = args.ph_lo, hi = args.ph_hi;
    XcdBarrier bar; bar.bar = ctl_words(ws) + CW_BAR + args.li * XCD_BAR_WORDS; bar.x = 0; bar.st = (volatile LAS unsigned*)(F.lds + BAR_LDS_OFF);
    {
        if (threadIdx.x == 0) { bar.st[0] = 0u; bar.st[1] = 0u; }
        __syncthreads();
        bar = xcd_barrier_post(ctl_words(ws) + CW_BAR + args.li * XCD_BAR_WORDS, (volatile LAS unsigned*)(F.lds + BAR_LDS_OFF));
    }
#define IN(k) (lo <= (k) && (k) < hi)
#define REPS(k) (IN(k) ? 1 + ((DUP_MASK >> (k)) & 1) : 0)
#define SEAM(k) do { if (IN(k) && IN((k) + 1)) { xcd_barrier(bar); if (BAR_DUP) xcd_barrier(bar); } } while (0)
    for (int rep_ = 0; rep_ < REPS(0); ++rep_) { p0_convert(F, args); }
    SEAM(0);
    for (int rep_ = 0; rep_ < REPS(1); ++rep_) {
        pg8::Gemm g{1024, 1024, 1024}; pg8::StaticOrder S; S.init(T, 2048, F.G, (int)blockIdx.x, ws + WS_C, ws + WS_WA_IN, 1024, 1024);
        pg8::EpiBf16<1> E{(bf16*)(ws + WS_B), 2048, args.in[3], 1.f};
        pg8::gemm_phase<pg8::EpiBf16<1>, pg8::StaticOrder, false>(F.lds, g, S, E);
    }
    SEAM(1);
    for (int rep_ = 0; rep_ < REPS(2); ++rep_) { p2_spatial(F, args); }
    SEAM(2);
    for (int rep_ = 0; rep_ < REPS(3); ++rep_) {
        pg8::Gemm g{1024, 1024, 1024}; pg8::StaticOrder S; S.init(T, 1024, F.G, (int)blockIdx.x, ws + WS_A, ws + WS_WA_OUT, 1024, 1024);
        pg8::EpiRes<false> E{(const bf16*)(ws + WS_C), (bf16*)(ws + WS_B), 1024, ALPHA};
        pg8::gemm_phase<pg8::EpiRes<false>, pg8::StaticOrder, false>(F.lds, g, S, E);
    }
    SEAM(3);
    tail_phases(F, args, bar, lo, hi, 4, 0, (const bf16*)(ws + WS_B), nullptr, (bf16*)(ws + WS_C));
    SEAM(8);
    for (int rep_ = 0; rep_ < REPS(9); ++rep_) {
        pg8::Gemm g{1024, 1024, 1024}; pg8::StaticOrder S; S.init(T, 3072, F.G, (int)blockIdx.x, ws + WS_C, ws + WS_WB_IN, 1024, 1024);
        EpiProj E{(bf16*)(ws + WS_D), ws + WS_KF};
        pg8::gemm_phase<EpiProj, pg8::StaticOrder, false>(F.lds, g, S, E);
    }
    SEAM(9);
    for (int rep_ = 0; rep_ < REPS(10); ++rep_) { p10_index(F, args, bar, rep_ == 0 && args.pad == 0); }
    SEAM(10);
    for (int rep_ = 0; rep_ < REPS(11); ++rep_) { p11_attn(F); }
    SEAM(11);
    for (int rep_ = 0; rep_ < REPS(12); ++rep_) {
        pg8::Gemm g{2048, 2048, 2048}; pg8::StaticOrder S; S.init(T, 1024, F.G, (int)blockIdx.x, ws + WS_B, ws + WS_WB_COMB, 2048, 2048);
        pg8::EpiRes<false> E{(const bf16*)(ws + WS_C), (bf16*)(ws + WS_F), 1024, ALPHA};
        pg8::gemm_phase<pg8::EpiRes<false>, pg8::StaticOrder, false>(F.lds, g, S, E);
    }
    SEAM(12);
    tail_phases(F, args, bar, lo, hi, 13, 1, (const bf16*)(ws + WS_F), args.out, nullptr);
#undef IN
#undef SEAM
#if CTL_GLOBAL
    if (F.wave == 0) {
        unsigned* ctl = ctl_words(ws); int lane = (int)threadIdx.x; asm volatile("" : "+v"(lane));
        unsigned old = 0u;
        if (lane == 0) { asm volatile("s_waitcnt vmcnt(0)" ::: "memory"); old = xb_add(&ctl[CW_DONE], 1u); }
        old = (unsigned)__builtin_amdgcn_readfirstlane((int)old);
        if (old + 1u == (unsigned)F.G) {
            unsigned* b = ctl + CW_BAR;
            if (lane < 16) { b[XB_XCNT(lane)] = 0u; b[XB_XSUB(lane)] = 0u; b[XB_XGEN(lane)] = 0u; }
            ctl[CW_COUNTS + lane] = 0u;
            if (lane == 0) { b[XB_TOP] = 0u; b[XB_TOPGEN] = 0u; b[XB_TMO] = 0u; ctl[CW_DONE] = 0u; }
        }
    }
#endif
}


extern "C" void kernel_launch(void* const* d_in, const int* in_sizes, int n_in, void* d_out, int out_size, void* d_ws, size_t ws_size, hipStream_t stream) {
    const size_t UNIT = (size_t)T * 1024 * 4;
    static int grid = 0;
    if (grid == 0) {
        if (n_in != 27 || ws_size < 8 * UNIT || out_size != T * D) { fprintf(stderr, "kernel_launch: unexpected shapes n_in %d ws %zu out %d\n", n_in, ws_size, out_size); grid = -1; return; }
        int dev = 0, cus = 0;
        if (hipGetDevice(&dev) != hipSuccess || hipDeviceGetAttribute(&cus, hipDeviceAttributeMultiprocessorCount, dev) != hipSuccess) { grid = -1; return; }
        if (hipFuncSetAttribute((const void*)mega, hipFuncAttributeMaxDynamicSharedMemorySize, LDS_BYTES) != hipSuccess) { fprintf(stderr, "hipFuncSetAttribute failed\n"); grid = -1; return; }
        grid = cus;
    }
    if (grid < 0) return;
    char* ws = (char*)d_ws;

#if !CTL_GLOBAL
    hipMemsetAsync(ws + WS_CTL, 0, CTL_ZERO_BYTES, stream);
#endif
    Args a{};
    for (int i = 0; i < 27; ++i) a.in[i] = (const float*)d_in[i];
    a.out = (float*)d_out; a.ws = (unsigned char*)d_ws;
    int nlaunch = 0;
    auto phase = [&](int lo, int hi) { a.ph_lo = lo; a.ph_hi = hi; a.li = (nlaunch++) % 3; hipLaunchKernelGGL(mega, dim3(grid), dim3(NWAVES * 64), LDS_BYTES, stream, a); };
    constexpr int NPHASE = 18;
#if defined(DUP_PHASE)
    phase(0, DUP_PHASE + 1); a.pad = 1; phase(DUP_PHASE, DUP_PHASE + 1); a.pad = 0; if (DUP_PHASE + 1 < NPHASE) phase(DUP_PHASE + 1, NPHASE);
#elif defined(MK_PER_PHASE)
    for (int ph = 0; ph < NPHASE; ++ph) phase(ph, ph + 1);
#else
    phase(0, NPHASE);
#endif
}
```
